# Optimizing an MI355X kernel written in HIP

```python
import jax
import jax.numpy as jnp
from jax import lax
import numpy as np

D_MODEL = 1024
BATCH = 2
SEQ = 16384
DEPTH = 2

GRID_W = 64
CTX_LEN = 256
HEAD_DIM = 64
MIX_W = D_MODEL // 4
N_BRANCH = 4
CONV_K = 3
WIN_HEADS = MIX_W // HEAD_DIM
WIN_KV_HEADS = WIN_HEADS // 2
WINDOW = 128
WIN_BLOCK = 128
LRU_BLOCKS = 4
LRU_CONV_K = 4
LRU_C = 8.0
NA_HEADS = MIX_W // HEAD_DIM
NA_ROWS = 8
NA_COLS = 16
D_FF = 256 * ((8 * D_MODEL // 3 + 255) // 256)
ROPE_BASE = 10000.0
EPS = 1e-6
NEG_INF = -1e30
N_MOD = 9
IN_SIZES = (MIX_W, MIX_W, MIX_W,
            WIN_HEADS * HEAD_DIM, WIN_KV_HEADS * HEAD_DIM, WIN_KV_HEADS * HEAD_DIM,
            MIX_W, MIX_W,
            NA_HEADS * HEAD_DIM, NA_HEADS * HEAD_DIM, NA_HEADS * HEAD_DIM,
            N_BRANCH * D_MODEL)
IN_W = sum(IN_SIZES)

kernel_name = 'hybrid_dit_prefix_gated_mixers'


def rms_norm(x, g):
    xf = x.astype(jnp.float32)
    y = xf * lax.rsqrt(jnp.mean(xf * xf, axis=-1, keepdims=True) + EPS)
    return (y * g.astype(jnp.float32)).astype(x.dtype)


def adaln(x, g, shift, scale):
    return rms_norm(x, g) * (1 + scale) + shift


def swiglu(h, w_gate, w_up, w_down):
    return (jax.nn.silu(h @ w_gate) * (h @ w_up)) @ w_down


def split_columns(u):
    points, acc = [], 0
    for size in IN_SIZES[:-1]:
        acc += size
        points.append(acc)
    return jnp.split(u, points, axis=-1)


def split_heads(t, n_heads):
    return t.reshape(t.shape[0], t.shape[1], n_heads, HEAD_DIM)


def dw_conv(x, w, pad_left):
    k, ch = w.shape
    return lax.conv_general_dilated(
        x, w[:, None, :].astype(x.dtype), window_strides=(1,),
        padding=[(pad_left, k - 1 - pad_left)],
        dimension_numbers=('NWC', 'WIO', 'NWC'), feature_group_count=ch)


def axial_rope(t, rows, cols):
    half = HEAD_DIM // 2
    nf = half // 2
    inv_freq = ROPE_BASE ** (-jnp.arange(nf, dtype=jnp.float32) / nf)

    def rotate(u, pos):
        ang = pos.astype(jnp.float32)[:, None] * inv_freq[None, :]
        cos = jnp.cos(ang)[None, :, None, :].astype(u.dtype)
        sin = jnp.sin(ang)[None, :, None, :].astype(u.dtype)
        u1, u2 = u[..., :nf], u[..., nf:]
        return jnp.concatenate([u1 * cos - u2 * sin, u1 * sin + u2 * cos], axis=-1)

    return jnp.concatenate([rotate(t[..., :half], rows), rotate(t[..., half:], cols)], axis=-1)


def context_attention(q, k, v, sink):
    b, l, hq, d = q.shape
    hkv = k.shape[2]
    g = hq // hkv
    qg = q.reshape(b, l, hkv, g, d)
    s = jnp.einsum('bqhgd,bkhd->bhgqk', qg, k).astype(jnp.float32) * (d ** -0.5)
    if sink is not None:
        s_sink = jnp.broadcast_to(sink.astype(jnp.float32).reshape(1, hkv, g, 1, 1), s.shape[:-1] + (1,))
        s = jnp.concatenate([s, s_sink], axis=-1)
    p = jax.nn.softmax(s, axis=-1)[..., :l].astype(v.dtype)
    o = jnp.einsum('bhgqk,bkhd->bqhgd', p, v)
    return o.reshape(b, l, hq * d)


def window_attention(q_rot, q_plain, k_rot, v, kc, vc, sink):
    b, n_tok, hq, d = q_rot.shape
    hkv = k_rot.shape[2]
    g = hq // hkv
    nb = n_tok // WIN_BLOCK
    scale = d ** -0.5
    qb = q_rot.reshape(b, nb, WIN_BLOCK, hkv, g, d)
    qcb = q_plain.reshape(b, nb, WIN_BLOCK, hkv, g, d)

    def band(t):
        tp = jnp.pad(t, ((0, 0), (WIN_BLOCK, WIN_BLOCK), (0, 0), (0, 0)))
        tp = tp.reshape(b, nb + 2, WIN_BLOCK, hkv, d)
        return jnp.concatenate([tp[:, :-2], tp[:, 1:-1], tp[:, 2:]], axis=2)

    kb, vb = band(k_rot), band(v)
    blk = jnp.arange(nb)[:, None, None]
    q_pos = blk * WIN_BLOCK + jnp.arange(WIN_BLOCK)[None, :, None]
    k_pos = (blk - 1) * WIN_BLOCK + jnp.arange(3 * WIN_BLOCK)[None, None, :]
    valid = (jnp.abs(k_pos - q_pos) <= WINDOW) & (k_pos >= 0) & (k_pos < n_tok)
    s_loc = jnp.einsum('bnqhgd,bnkhd->bnhgqk', qb, kb).astype(jnp.float32) * scale
    s_loc = jnp.where(valid[None, :, None, None], s_loc, NEG_INF)
    s_ctx = jnp.einsum('bnqhgd,blhd->bnhgql', qcb, kc).astype(jnp.float32) * scale
    s_sink = jnp.broadcast_to(sink.astype(jnp.float32).reshape(1, 1, hkv, g, 1, 1), s_loc.shape[:-1] + (1,))
    n_loc = 3 * WIN_BLOCK
    n_ctx = kc.shape[1]
    probs = jax.nn.softmax(jnp.concatenate([s_loc, s_ctx, s_sink], axis=-1), axis=-1).astype(v.dtype)
    o = (jnp.einsum('bnhgqk,bnkhd->bnqhgd', probs[..., :n_loc], vb)
         + jnp.einsum('bnhgql,blhd->bnqhgd', probs[..., n_loc:n_loc + n_ctx], vc))
    return o.reshape(b, n_tok, hq * d)


def neighbourhood_attention(q, k, v, kc, vc, rel_bias):
    b, n_tok, h, d = q.shape
    rows = n_tok // GRID_W
    kr = min(NA_ROWS, rows)
    ncb = GRID_W // NA_COLS
    cb = 2 * NA_COLS
    r = jnp.arange(rows)
    row_idx = jnp.clip(r - kr // 2, 0, rows - kr)[:, None] + jnp.arange(kr)[None, :]
    col_idx = (jnp.clip(jnp.arange(ncb) * NA_COLS - NA_COLS // 2, 0, GRID_W - cb)[:, None]
               + jnp.arange(cb)[None, :])
    q_col = jnp.arange(ncb)[:, None] * NA_COLS + jnp.arange(NA_COLS)[None, :]
    c_start = jnp.clip(q_col - NA_COLS // 2, 0, GRID_W - NA_COLS)[:, :, None]
    col_valid = (col_idx[:, None, :] >= c_start) & (col_idx[:, None, :] < c_start + NA_COLS)
    dr = row_idx - r[:, None] + NA_ROWS - 1
    dc = jnp.clip(col_idx[:, None, :] - q_col[:, :, None], 1 - NA_COLS, NA_COLS - 1) + NA_COLS - 1
    bias = rel_bias[:, dr[:, None, None, :, None], dc[None, :, :, None, :]]
    bias = jnp.transpose(bias, (1, 2, 0, 3, 4, 5)).astype(jnp.float32)
    qg = q.reshape(b, rows, ncb, NA_COLS, h, d)
    gi, gj = row_idx[:, None, :, None], col_idx[None, :, None, :]
    kg = k.reshape(b, rows, GRID_W, h, d)[:, gi, gj]
    vg = v.reshape(b, rows, GRID_W, h, d)[:, gi, gj]
    scale = d ** -0.5
    s_loc = jnp.einsum('brnqhd,brnkchd->brnhqkc', qg, kg).astype(jnp.float32) * scale + bias
    s_loc = jnp.where(col_valid[None, None, :, None, :, None, :], s_loc, NEG_INF)
    s_ctx = jnp.einsum('brnqhd,blhd->brnhql', qg, kc).astype(jnp.float32) * scale
    n_loc = kr * cb
    scores = jnp.concatenate([s_loc.reshape(s_ctx.shape[:-1] + (n_loc,)), s_ctx], axis=-1)
    probs = jax.nn.softmax(scores, axis=-1).astype(v.dtype)
    p_loc = probs[..., :n_loc].reshape(s_loc.shape)
    o = (jnp.einsum('brnhqkc,brnkchd->brnqhd', p_loc, vg)
         + jnp.einsum('brnhql,blhd->brnqhd', probs[..., n_loc:], vc))
    return o.reshape(b, n_tok, h * d)


def short_conv_mixer(u, gate_b, gate_c, w_conv):
    return gate_b * dw_conv(gate_c * u, w_conv, CONV_K // 2)


def rglru_coeffs(u, w_a, b_a, w_x, b_x, lam):
    b, t, w = u.shape
    ub = u.reshape(b, t, LRU_BLOCKS, w // LRU_BLOCKS)
    r = jax.nn.sigmoid(jnp.einsum('btnc,nce->btne', ub, w_a).reshape(b, t, w) + b_a).astype(jnp.float32)
    i = jax.nn.sigmoid(jnp.einsum('btnc,nce->btne', ub, w_x).reshape(b, t, w) + b_x)
    log_a = -LRU_C * r * jax.nn.softplus(-lam.astype(jnp.float32))
    return jnp.exp(log_a), jnp.sqrt(-jnp.expm1(2.0 * log_a)) * (i * u).astype(jnp.float32)


def linear_scan(a, b, h0, reverse):
    if h0 is not None:
        t0 = a.shape[1] - 1 if reverse else 0
        b = b.at[:, t0].add(a[:, t0] * h0)

    def combine(e1, e2):
        return e1[0] * e2[0], e2[0] * e1[1] + e2[1]

    _, h = lax.associative_scan(combine, (a, b), reverse=reverse, axis=1)
    return h


def rglru_mixer(xr, gr, xrc, grc, p, ctx_out):
    u = dw_conv(xr, p['lru_conv_w'], LRU_CONV_K // 2) + p['lru_conv_b']
    uc = dw_conv(xrc, p['lru_conv_w'], LRU_CONV_K // 2) + p['lru_conv_b']
    h_lat, h_ctx = [], []
    for direction, reverse in ((0, False), (1, True)):
        prm = (p['lru_w_a'][direction], p['lru_b_a'][direction], p['lru_w_x'][direction],
               p['lru_b_x'][direction], p['lru_lam'][direction])
        a_c, b_c = rglru_coeffs(uc, *prm)
        hc = linear_scan(a_c, b_c, None, reverse)
        h0 = hc[:, 0] if reverse else hc[:, -1]
        a_l, b_l = rglru_coeffs(u, *prm)
        h_lat.append(linear_scan(a_l, b_l, h0, reverse))
        h_ctx.append(hc)
    y = (h_lat[0] + h_lat[1]).astype(xr.dtype) * jax.nn.gelu(gr)
    if not ctx_out:
        return y, None
    return y, (h_ctx[0] + h_ctx[1]).astype(xrc.dtype) * jax.nn.gelu(grc)


def merge_branches(ys, gate_logits, w_branch, b_gate, w_out):
    b, t, _ = gate_logits.shape
    g = jax.nn.sigmoid(gate_logits + b_gate).reshape(b, t, N_BRANCH, D_MODEL)
    merged = g[:, :, 0] * (ys[0] @ w_branch[0])
    for n in range(1, N_BRANCH):
        merged = merged + g[:, :, n] * (ys[n] @ w_branch[n])
    return merged @ w_out


def token_mixer(h, hc, p, ctx_out):
    n_tok = h.shape[1]
    (ax, ab, ac, bq, bk, bv, cx, cg, dq, dk, dv, gl) = split_columns(h @ p['w_in'])
    (axc, abc, acc, bqc, bkc, bvc, cxc, cgc, dqc, dkc, dvc, glc) = split_columns(hc @ p['w_in'])
    gq_b, gk_b, gq_d, gk_d = p['qk_norm_g'][0], p['qk_norm_g'][1], p['qk_norm_g'][2], p['qk_norm_g'][3]
    pos = jnp.arange(n_tok)
    rows, cols = pos // GRID_W, pos % GRID_W
    qb = rms_norm(split_heads(bq, WIN_HEADS), gq_b)
    kb = rms_norm(split_heads(bk, WIN_KV_HEADS), gk_b)
    vb = split_heads(bv, WIN_KV_HEADS)
    kbc = rms_norm(split_heads(bkc, WIN_KV_HEADS), gk_b)
    vbc = split_heads(bvc, WIN_KV_HEADS)
    y_b = window_attention(axial_rope(qb, rows, cols), qb, axial_rope(kb, rows, cols), vb, kbc, vbc,
                           p['attn_sink'])
    qd = rms_norm(split_heads(dq, NA_HEADS), gq_d)
    kd = rms_norm(split_heads(dk, NA_HEADS), gk_d)
    vd = split_heads(dv, NA_HEADS)
    kdc = rms_norm(split_heads(dkc, NA_HEADS), gk_d)
    vdc = split_heads(dvc, NA_HEADS)
    y_d = neighbourhood_attention(qd, kd, vd, kdc, vdc, p['na_rel_bias'])
    y_a = short_conv_mixer(ax, ab, ac, p['conv_a_w'])
    y_c, y_c_ctx = rglru_mixer(cx, cg, cxc, cgc, p, ctx_out)
    out = merge_branches((y_a, y_b, y_c, y_d), gl, p['w_branch'], p['b_gate'], p['w_out'])
    if not ctx_out:
        return out, None
    qbc = rms_norm(split_heads(bqc, WIN_HEADS), gq_b)
    qdc = rms_norm(split_heads(dqc, NA_HEADS), gq_d)
    ys_ctx = (short_conv_mixer(axc, abc, acc, p['conv_a_w']),
              context_attention(qbc, kbc, vbc, p['attn_sink']),
              y_c_ctx,
              context_attention(qdc, kdc, vdc, None))
    return out, merge_branches(ys_ctx, glc, p['w_branch'], p['b_gate'], p['w_out'])


def layer(x, xc, mod_x, mod_c, p, ctx_out):
    mx = jnp.split(mod_x[:, None, :], N_MOD, axis=-1)
    mc = jnp.split(mod_c[:, None, :], N_MOD, axis=-1)
    g = p['norm_g']

    def half_ffn(t, m, i):
        j = 6 * i
        hh = adaln(t, g[2 * i], m[j], m[j + 1])
        return t + 0.5 * m[j + 2] * swiglu(hh, p['ffn_w_gate'][i], p['ffn_w_up'][i], p['ffn_w_down'][i])

    x = half_ffn(x, mx, 0)
    xc = half_ffn(xc, mc, 0)
    y, yc = token_mixer(adaln(x, g[1], mx[3], mx[4]), adaln(xc, g[1], mc[3], mc[4]), p, ctx_out)
    x = half_ffn(x + mx[5] * y, mx, 1)
    if not ctx_out:
        return x, None
    xc = half_ffn(xc + mc[5] * yc, mc, 1)
    return x, xc


def setup_inputs(seed: int = 0) -> dict:
    key = jax.random.key(seed)
    ks = jax.random.split(key, 26)
    f32 = jnp.float32

    def nrm(k, shape, scale):
        return scale * jax.random.normal(k, shape, f32)

    blk = MIX_W // LRU_BLOCKS
    u = jax.random.uniform(ks[20], (DEPTH, 2, MIX_W), f32, 0.9, 0.999)
    s = u ** (1.0 / LRU_C)
    lam = jnp.log(s) - jnp.log1p(-s)
    return {
        'x': nrm(ks[0], (BATCH, SEQ, D_MODEL), 1.0),
        'c': nrm(ks[1], (BATCH, D_MODEL), 1.0),
        'ctx': nrm(ks[2], (BATCH, CTX_LEN, D_MODEL), 1.0),
        'c_ctx': nrm(ks[3], (D_MODEL,), 1.0),
        'w_mod': nrm(ks[4], (DEPTH, D_MODEL, N_MOD * D_MODEL), 0.5 * D_MODEL ** -0.5),
        'b_mod': nrm(ks[5], (DEPTH, N_MOD * D_MODEL), 0.01),
        'norm_g': 1.0 + nrm(ks[6], (DEPTH, 3, D_MODEL), 0.02),
        'ffn_w_gate': nrm(ks[7], (DEPTH, 2, D_MODEL, D_FF), D_MODEL ** -0.5),
        'ffn_w_up': nrm(ks[8], (DEPTH, 2, D_MODEL, D_FF), D_MODEL ** -0.5),
        'ffn_w_down': nrm(ks[9], (DEPTH, 2, D_FF, D_MODEL), D_FF ** -0.5),
        'w_in': nrm(ks[10], (DEPTH, D_MODEL, IN_W), D_MODEL ** -0.5),
        'b_gate': nrm(ks[11], (DEPTH, N_BRANCH * D_MODEL), 0.1),
        'conv_a_w': nrm(ks[12], (DEPTH, CONV_K, MIX_W), CONV_K ** -0.5),
        'qk_norm_g': 1.0 + nrm(ks[13], (DEPTH, 4, HEAD_DIM), 0.02),
        'attn_sink': nrm(ks[14], (DEPTH, WIN_HEADS), 0.5),
        'lru_conv_w': nrm(ks[15], (DEPTH, LRU_CONV_K, MIX_W), LRU_CONV_K ** -0.5),
        'lru_conv_b': nrm(ks[16], (DEPTH, MIX_W), 0.01),
        'lru_w_a': nrm(ks[17], (DEPTH, 2, LRU_BLOCKS, blk, blk), blk ** -0.5),
        'lru_b_a': nrm(ks[18], (DEPTH, 2, MIX_W), 0.01),
        'lru_w_x': nrm(ks[19], (DEPTH, 2, LRU_BLOCKS, blk, blk), blk ** -0.5),
        'lru_b_x': nrm(ks[21], (DEPTH, 2, MIX_W), 0.01),
        'lru_lam': lam,
        'na_rel_bias': nrm(ks[22], (DEPTH, NA_HEADS, 2 * NA_ROWS - 1, 2 * NA_COLS - 1), 0.1),
        'w_branch': nrm(ks[23], (DEPTH, N_BRANCH, MIX_W, D_MODEL), MIX_W ** -0.5),
        'w_out': nrm(ks[24], (DEPTH, D_MODEL, D_MODEL), D_MODEL ** -0.5),
    }


def reference(x, c, ctx, c_ctx, w_mod, b_mod, norm_g, ffn_w_gate, ffn_w_up, ffn_w_down, w_in, b_gate,
              conv_a_w, qk_norm_g, attn_sink, lru_conv_w, lru_conv_b, lru_w_a, lru_b_a, lru_w_x, lru_b_x,
              lru_lam, na_rel_bias, w_branch, w_out):
    xc = ctx
    for l in range(DEPTH):
        ctx_out = l < DEPTH - 1
        mod_x = jax.nn.silu(c) @ w_mod[l] + b_mod[l]
        mod_c = (jax.nn.silu(c_ctx) @ w_mod[l] + b_mod[l])[None, :]
        p = dict(norm_g=norm_g[l], ffn_w_gate=ffn_w_gate[l], ffn_w_up=ffn_w_up[l], ffn_w_down=ffn_w_down[l],
                 w_in=w_in[l], b_gate=b_gate[l], conv_a_w=conv_a_w[l], qk_norm_g=qk_norm_g[l],
                 attn_sink=attn_sink[l], lru_conv_w=lru_conv_w[l], lru_conv_b=lru_conv_b[l],
                 lru_w_a=lru_w_a[l], lru_b_a=lru_b_a[l], lru_w_x=lru_w_x[l], lru_b_x=lru_b_x[l],
                 lru_lam=lru_lam[l], na_rel_bias=na_rel_bias[l], w_branch=w_branch[l], w_out=w_out[l])
        x, xc = layer(x, xc, mod_x, mod_c, p, ctx_out)
    return x
```

```cpp
#include <hip/hip_runtime.h>
#include <hip/hip_cooperative_groups.h>
#include <cstdio>
#include <cstdint>
namespace cg = cooperative_groups;


#ifndef KMASK
#define KMASK 0xFFFF
#endif
#define EN(k) (((KM) >> (k)) & 1)
#ifndef DBL_MASK
#define DBL_MASK 0
#endif
#ifndef XSYNC
#define XSYNC 0
#endif
#define LAS __attribute__((address_space(3)))
typedef unsigned short bf16_t;
typedef short bf16x8 __attribute__((ext_vector_type(8)));
typedef float f32x4 __attribute__((ext_vector_type(4)));
typedef float f32x2 __attribute__((ext_vector_type(2)));
typedef float f32x16 __attribute__((ext_vector_type(16)));
typedef unsigned u32x4 __attribute__((ext_vector_type(4)));
typedef unsigned u32x2 __attribute__((ext_vector_type(2)));

constexpr int D = 1024, SEQ = 16384, CTXL = 256, DFF = 2816, INW = 6656, NMIX = 2560;
constexpr int ML = 2 * SEQ, MC = 2 * CTXL, MT = ML + MC;
constexpr int NMOD = 9 * D;
constexpr float EPS = 1e-6f;
constexpr float LOG2E = 1.4426950408889634f;

constexpr size_t MiB = 1u << 20;
constexpr size_t OFF_MOD = 1 * MiB;
constexpr size_t OFF_GS = OFF_MOD + 256 * 1024;
constexpr size_t OFF_BIAS = OFF_GS + 128 * 1024;
constexpr size_t OFF_ROPE = OFF_BIAS + 256 * 1024;
constexpr size_t OFF_LRUC = OFF_ROPE + 64 * 1024;
constexpr size_t OFF_SUM = 2 * MiB;
constexpr size_t OFF_SSQ = 4 * MiB;
constexpr size_t OFF_XC = 7 * MiB;
constexpr size_t OFF_W = 9 * MiB;
constexpr size_t W_W1A = OFF_W;
constexpr size_t W_WDA = W_W1A + (size_t)5632 * 1024 * 2;
constexpr size_t W_WIN = W_WDA + (size_t)1024 * 2816 * 2;
constexpr size_t W_WBR = W_WIN + (size_t)6656 * 1024 * 2;
constexpr size_t W_WOUT = W_WBR + (size_t)(4096 + 128) * 256 * 2;
constexpr size_t W_W1B = W_WOUT + (size_t)1024 * 1024 * 2;
constexpr size_t W_WDB = W_W1B + (size_t)5632 * 1024 * 2;
constexpr size_t W_WLRU = W_WDB + (size_t)1024 * 2816 * 2;
constexpr size_t W_END = W_WLRU + (size_t)1024 * 256 * 2;
constexpr size_t OFF_XA = 61 * MiB;
constexpr size_t OFF_XB = 126 * MiB;
constexpr size_t OFF_R = 191 * MiB;
constexpr size_t OFF_GL = OFF_R + (size_t)MT * NMIX * 2;
constexpr size_t OFF_PART = 486 * MiB;
constexpr size_t WS_NEED = OFF_PART + (size_t)11 * MC * D * 4;
static_assert(OFF_GL + (size_t)66 * 256 * 4096 * 2 <= OFF_PART, "gl/part");
static_assert(W_END <= OFF_XA, "weights");
static_assert(OFF_XA + (size_t)MT * D * 2 <= OFF_XB && OFF_XB + (size_t)MT * D * 2 <= OFF_R, "xa/xb");
static_assert((size_t)4 * MT * 256 * 4 <= (size_t)66 * 256 * 4096 * 2, "ab fits gl");
static_assert(WS_NEED <= 512 * MiB, "ws");

constexpr int LDS_BYTES = 147456;

struct Params { const float* in[25]; float* out; unsigned char* ws; int lo, hi; };

__device__ __forceinline__ float bflo(unsigned w) { return __uint_as_float(w << 16); }
__device__ __forceinline__ float bfhi(unsigned w) { return __uint_as_float(w & 0xffff0000u); }
__device__ __forceinline__ float bf1(bf16_t u) { return __uint_as_float((unsigned)u << 16); }
typedef __bf16 bf16x2_t __attribute__((ext_vector_type(2)));
__device__ __forceinline__ unsigned cvt_pk(float lo, float hi) { const f32x2 v = {lo, hi}; const bf16x2_t b = __builtin_convertvector(v, bf16x2_t); return __builtin_bit_cast(unsigned, b); }
__device__ __forceinline__ float fast_sigmoid(float v) { return __builtin_amdgcn_rcpf(1.0f + __expf(-v)); }
__device__ __forceinline__ float wave_sum(float v) {
#pragma unroll
    for (int o = 1; o < 64; o <<= 1) v += __shfl_xor(v, o);
    return v;
}
__device__ __forceinline__ int mi_of_tile(int pm) { return pm < 64 ? 0 : (pm < 128 ? 1 : 2); }
__device__ __forceinline__ float row_rstd(const float* ssq, int row) {
    const f32x4* p = (const f32x4*)(ssq + (size_t)row * 16);
    const f32x4 a = p[0], b = p[1], c = p[2], d = p[3];
    const float s = ((a.x + a.y) + (a.z + a.w)) + ((b.x + b.y) + (b.z + b.w)) + ((c.x + c.y) + (c.z + c.w)) + ((d.x + d.y) + (d.z + d.w));
    return rsqrtf(s * (1.0f / 1024.0f) + EPS);
}

namespace pg8 {
constexpr int BM = 256, BK = 64, HALF = 128, HTB = HALF * BK * 2, NXCD = 8, WGM = 8;
__host__ __device__ __forceinline__ int lds_byte(int r, int c) { const int st = (r >> 4) * 2 + (c >> 5), rr = r & 15, cc = c & 31, ob = rr * 64 + cc * 2; return st * 1024 + (ob ^ (((ob >> 9) & 1) << 5)); }
__host__ __device__ __forceinline__ void stage_rc(int b, int& R, int& C) { const int st = b / 1024, sb = b % 1024, swz = sb ^ (((sb >> 9) & 1) << 5); R = (st >> 1) * 16 + swz / 64; C = (st & 1) * 32 + (swz % 64) / 2; }
__host__ __device__ __forceinline__ int perm32(int rho) { const int n = rho >> 4, i = rho & 15; return 8 * (i >> 2) + 4 * n + (i & 3); }

struct Unit { int pm, pn, aux, nt; const char* A; const char* B; };

struct SchedStd {
    int m0, nM, nN, nwg, G, c, nt; const char* A; const char* B; size_t tA, tB;
    __device__ __forceinline__ void init(int m0_, int nM_, int nN_, int G_, int c_, const void* A_, int lda, const void* B_, int ldb, int K_) {
        m0 = m0_; nM = nM_; nN = nN_; nwg = nM * nN; G = G_; c = c_; nt = K_ / BK; A = (const char*)A_; B = (const char*)B_; tA = (size_t)BM * lda * 2; tB = (size_t)BM * ldb * 2; }
    __device__ __forceinline__ bool next(int i, Unit& u) const {
        const long L = (long)i * G + c; if (L >= nwg) return false;
        int wgid = (int)L; { const int q = nwg / NXCD, r = nwg % NXCD, xcd = wgid % NXCD, off = wgid / NXCD; wgid = (xcd < r ? xcd * (q + 1) : r * (q + 1) + (xcd - r) * q) + off; }
        const int nig = WGM * nN, gid = wgid / nig, fm = gid * WGM, gsz = (nM - fm) < WGM ? (nM - fm) : WGM;
        const int pm = fm + ((wgid % nig) % gsz), pn = (wgid % nig) / gsz;
        u.pm = m0 + pm; u.pn = pn; u.aux = 0; u.nt = nt; u.A = A + (size_t)u.pm * tA; u.B = B + (size_t)pn * tB; return true;
    }
};
struct SchedDn {
    SchedStd std; int nctx;
    __device__ __forceinline__ bool next(int i, Unit& u) const {
        const int li = (std.c < nctx) ? i - 1 : i;
        if (li < 0) { const int pmc = std.c / 44, rest = std.c % 44, pn = rest / 11, ks = rest % 11;
            u.pm = 128 + pmc; u.pn = pn; u.aux = ks + 1; u.nt = 4; u.A = std.A + (size_t)u.pm * std.tA + ks * 512; u.B = std.B + (size_t)pn * std.tB + ks * 512; return true; }
        return std.next(li, u);
    }
};
struct SchedBr {
    int m0, nM, G, c; const char* A; const char* B;
    __device__ __forceinline__ bool next(int i, Unit& u) const {
        const int sup = i >> 2, b = i & 3; const long L = (long)sup * G + c; if (L >= (long)nM * 8) return false;
        u.pm = m0 + (int)(L >> 3); u.pn = (int)(L & 7); u.aux = b; u.nt = 4;
        u.A = A + (size_t)u.pm * (BM * 1024 * 2) + b * 512; u.B = B + (size_t)b * (1024 * 256 * 2) + (size_t)u.pn * (128 * 256 * 2); return true;
    }
};

template <class Epi, class Sched, int NBJ>
__device__ __forceinline__ void gemm_phase(LAS unsigned char* lds, const int tid, const int K, const int lda, const int ldb, const Sched& S, const Epi& E) {
    const int wid = __builtin_amdgcn_readfirstlane(tid >> 6), lane = tid & 63, wr = wid >> 2, wc = wid & 3, fr = lane & 15, fq = lane >> 4;
    unsigned voffA[2], voffB[2];
#pragma unroll
    for (int i = 0; i < 2; ++i) { int R, C; stage_rc(tid * 16 + i * 8192, R, C); const int Rb = (R & ~31) + perm32(R & 31);
        voffA[i] = (unsigned)(R * lda + C) * 2u; voffB[i] = (unsigned)(Rb * ldb + C) * 2u; }
    const size_t kstep = (size_t)(BK * 2);
    const size_t hA = (size_t)HALF * lda * 2, hB = (size_t)HALF * ldb * 2;
    const unsigned ldsw = (unsigned)wid * 1024u;
    const int aoff = lds_byte(wr * 64 + fr, fq * 8), boff = lds_byte(wc * 32 + fr, fq * 8);
#define PG8_SA(b, h) (((b) * 2 + (h)) * HTB)
#define PG8_SB(b, h) ((4 + (b) * 2 + (h)) * HTB)
#define PG8_STAGE(bufoff, gbase, voff) do { _Pragma("unroll") for (int _i = 0; _i < 2; ++_i) \
        __builtin_amdgcn_global_load_lds((const unsigned*)((const char*)(gbase) + (voff)[_i]), (LAS unsigned*)(lds + (bufoff) + ldsw + _i * 8192), 16, 0, 0); } while (0)
#define PG8_LDA(dst, b, h) do { _Pragma("unroll") for (int m = 0; m < 4; ++m) _Pragma("unroll") for (int k = 0; k < 2; ++k) dst[m][k] = *(const LAS bf16x8*)(lds + PG8_SA(b, h) + aoff + m * 2048 + k * 1024); } while (0)
#define PG8_LDB(dst, b, h) do { _Pragma("unroll") for (int n = 0; n < 2; ++n) _Pragma("unroll") for (int k = 0; k < 2; ++k) dst[n][k] = *(const LAS bf16x8*)(lds + PG8_SB(b, h) + boff + n * 2048 + k * 1024); } while (0)
#define PG8_MMA(ai, bj, At, Bt) do { if ((bj) < NBJ) { __builtin_amdgcn_s_setprio(1); _Pragma("unroll") for (int m = 0; m < 4; ++m) _Pragma("unroll") for (int n = 0; n < 2; ++n) _Pragma("unroll") for (int k = 0; k < 2; ++k) \
        acc[ai][bj][m][n] = __builtin_amdgcn_mfma_f32_16x16x32_bf16(Bt[n][k], At[m][k], acc[ai][bj][m][n], 0, 0, 0); __builtin_amdgcn_s_setprio(0); } } while (0)
#define PG8_WAIT_V(n) asm volatile("s_waitcnt vmcnt(" #n ")" ::: "memory")
#define PG8_WAIT_L(n) asm volatile("s_waitcnt lgkmcnt(" #n ")" ::: "memory")
#define PG8_BAR __builtin_amdgcn_s_barrier()
#define PG8_SCHED __builtin_amdgcn_sched_barrier(0)
    Unit cur, nxt; int ui = 0;
    if (!S.next(0, cur)) return;
    f32x4 acc[2][2][4][2];
#pragma unroll
    for (int a = 0; a < 2; ++a)
#pragma unroll
        for (int b = 0; b < 2; ++b)
#pragma unroll
            for (int m = 0; m < 4; ++m)
#pragma unroll
                for (int n = 0; n < 2; ++n) acc[a][b][m][n] = (f32x4){0.f, 0.f, 0.f, 0.f};
    bf16x8 At[4][2], B0[2][2], B1[2][2];
    const char* cA = cur.A; const char* cB = cur.B;
    PG8_STAGE(PG8_SB(0, 0), cB, voffB); PG8_STAGE(PG8_SB(0, 1), cB + hB, voffB); PG8_STAGE(PG8_SA(0, 0), cA, voffA); PG8_STAGE(PG8_SA(0, 1), cA + hA, voffA);
    if (wr == 1) PG8_BAR;
    PG8_WAIT_V(2); PG8_BAR;
    PG8_STAGE(PG8_SB(1, 0), cB + kstep, voffB); PG8_STAGE(PG8_SA(1, 0), cA + kstep, voffA); PG8_STAGE(PG8_SB(1, 1), cB + hB + kstep, voffB);
    PG8_WAIT_V(6); PG8_BAR;
    for (;;) {
        const bool has_next = S.next(ui + 1, nxt);
        const char* nA = has_next ? nxt.A : cA; const char* nB = has_next ? nxt.B : cB;
        const int nt = cur.nt;
        for (int t = 0; t < nt; t += 2) {
            const bool last = (t == nt - 2);
            const char* a1 = cA + (size_t)(t + 1) * kstep;
            const char* a2 = last ? nA : cA + (size_t)(t + 2) * kstep; const char* b2 = last ? nB : cB + (size_t)(t + 2) * kstep;
            const char* a3 = a2 + kstep; const char* b3 = b2 + kstep;
            PG8_LDB(B0, 0, 0); PG8_LDB(B1, 0, 1); PG8_SCHED; PG8_LDA(At, 0, 0); PG8_STAGE(PG8_SA(1, 1), a1 + hA, voffA);
            PG8_WAIT_V(8); PG8_WAIT_L(0); PG8_BAR; PG8_MMA(0, 0, At, B0); PG8_MMA(0, 1, At, B1); PG8_BAR; PG8_SCHED;
            PG8_LDA(At, 0, 1); PG8_STAGE(PG8_SB(0, 0), b2, voffB); PG8_STAGE(PG8_SB(0, 1), b2 + hB, voffB); PG8_STAGE(PG8_SA(0, 0), a2, voffA);
            PG8_WAIT_V(8); PG8_WAIT_L(0); PG8_BAR; PG8_MMA(1, 0, At, B0); PG8_MMA(1, 1, At, B1); PG8_BAR; PG8_SCHED;
            PG8_LDB(B0, 1, 0); PG8_LDB(B1, 1, 1); PG8_SCHED; PG8_LDA(At, 1, 0); PG8_STAGE(PG8_SA(0, 1), a2 + hA, voffA);
            PG8_WAIT_V(8); PG8_WAIT_L(0); PG8_BAR; PG8_MMA(0, 0, At, B0); PG8_MMA(0, 1, At, B1); PG8_BAR; PG8_SCHED;
            PG8_LDA(At, 1, 1); PG8_STAGE(PG8_SB(1, 0), b3, voffB); PG8_STAGE(PG8_SB(1, 1), b3 + hB, voffB); PG8_STAGE(PG8_SA(1, 0), a3, voffA);
            PG8_WAIT_V(8); PG8_WAIT_L(0); PG8_BAR; PG8_MMA(1, 0, At, B0); PG8_MMA(1, 1, At, B1); PG8_BAR; PG8_SCHED;
        }
        if (wr == 0) PG8_BAR;
        { int fr_o = fr, fq_o = fq; asm volatile("" : "+v"(fr_o), "+v"(fq_o));
          E(acc, cur, wr, wc, fr_o, fq_o); }
        if (!has_next) break;
#pragma unroll
        for (int a = 0; a < 2; ++a)
#pragma unroll
            for (int b = 0; b < NBJ; ++b)
#pragma unroll
                for (int m = 0; m < 4; ++m)
#pragma unroll
                    for (int n = 0; n < 2; ++n) acc[a][b][m][n] = (f32x4){0.f, 0.f, 0.f, 0.f};
        cur = nxt; cA = nA; cB = nB; ++ui;
        if (wr == 1) PG8_BAR;
    }
    PG8_WAIT_V(0);
    PG8_BAR;
#undef PG8_SA
#undef PG8_SB
#undef PG8_STAGE
#undef PG8_LDA
#undef PG8_LDB
#undef PG8_MMA
#undef PG8_WAIT_V
#undef PG8_WAIT_L
#undef PG8_BAR
#undef PG8_SCHED
}

struct EpiSwiGLU {
    const float* ssq; const float* bias; bf16_t* act;
    __device__ __forceinline__ void operator()(f32x4 (&acc)[2][2][4][2], const Unit& u, int wr, int wc, int fr, int fq) const {
        const int mi = mi_of_tile(u.pm);
        const float* bs = bias + mi * 5632 + u.pn * 256 + wc * 32 + 8 * fq;
        const f32x4 bg0 = *(const f32x4*)(bs), bg1 = *(const f32x4*)(bs + 4), bu0 = *(const f32x4*)(bs + 128), bu1 = *(const f32x4*)(bs + 132);
        const int col = u.pn * 128 + wc * 32 + 8 * fq;
#pragma unroll
        for (int ai = 0; ai < 2; ++ai)
#pragma unroll
            for (int m = 0; m < 4; ++m) {
                const int row = u.pm * 256 + ai * 128 + wr * 64 + m * 16 + fr;
                const float rs = row_rstd(ssq, row);
                const f32x4 g0 = acc[ai][0][m][0] * rs + bg0, g1 = acc[ai][0][m][1] * rs + bg1, u0 = acc[ai][1][m][0] * rs + bu0, u1 = acc[ai][1][m][1] * rs + bu1;
                float o[8];
#pragma unroll
                for (int j = 0; j < 4; ++j) { o[j] = g0[j] * fast_sigmoid(g0[j]) * u0[j]; o[4 + j] = g1[j] * fast_sigmoid(g1[j]) * u1[j]; }
                u32x4 w; w.x = cvt_pk(o[0], o[1]); w.y = cvt_pk(o[2], o[3]); w.z = cvt_pk(o[4], o[5]); w.w = cvt_pk(o[6], o[7]);
                *(u32x4*)(act + (size_t)row * DFF + col) = w;
            }
    }
};
struct EpiRes {
    const float* xinL; const float* xinC; float* xoutL; float* xoutC; const float* gate; const float* gsn; bf16_t* xs; float* ssq; float* part; int wxs;
    __device__ __forceinline__ void operator()(f32x4 (&acc)[2][2][4][2], const Unit& u, int wr, int wc, int fr, int fq) const {
        const int mi = mi_of_tile(u.pm);
        const int col = u.pn * 256 + wc * 32 + 8 * fq;
        if (u.aux > 0) {
            float* pp = part + ((size_t)(u.aux - 1) * MC) * D + col;
#pragma unroll
            for (int ai = 0; ai < 2; ++ai)
#pragma unroll
                for (int m = 0; m < 4; ++m) {
                    const int row = u.pm * 256 + ai * 128 + wr * 64 + m * 16 + fr - ML;
#pragma unroll
                    for (int bj = 0; bj < 2; ++bj) { *(f32x4*)(pp + (size_t)row * D + bj * 128) = acc[ai][bj][m][0]; *(f32x4*)(pp + (size_t)row * D + bj * 128 + 4) = acc[ai][bj][m][1]; }
                }
            return;
        }
        f32x4 gv[2][2], gs[2][2];
#pragma unroll
        for (int bj = 0; bj < 2; ++bj)
#pragma unroll
            for (int n = 0; n < 2; ++n) {
                gv[bj][n] = *(const f32x4*)(gate + mi * NMOD + col + bj * 128 + 4 * n);
                gs[bj][n] = *(const f32x4*)(gsn + mi * 1024 + col + bj * 128 + 4 * n);
            }
        const bool lat = u.pm < 128;
        const float* xi = lat ? xinL : xinC - (size_t)ML * D; float* xo = lat ? xoutL : xoutC - (size_t)ML * D;
#pragma unroll
        for (int ai = 0; ai < 2; ++ai)
#pragma unroll
            for (int m = 0; m < 4; ++m) {
                const int row = u.pm * 256 + ai * 128 + wr * 64 + m * 16 + fr;
                const size_t off = (size_t)row * D + col;
                float ss = 0.f;
#pragma unroll
                for (int bj = 0; bj < 2; ++bj) {
                    const f32x4 x0 = __builtin_nontemporal_load((const f32x4*)(xi + off + bj * 128)) + gv[bj][0] * acc[ai][bj][m][0];
                    const f32x4 x1 = __builtin_nontemporal_load((const f32x4*)(xi + off + bj * 128 + 4)) + gv[bj][1] * acc[ai][bj][m][1];
                    __builtin_nontemporal_store(x0, (f32x4*)(xo + off + bj * 128)); __builtin_nontemporal_store(x1, (f32x4*)(xo + off + bj * 128 + 4));
                    if (wxs) {
                        ss += (x0[0] * x0[0] + x0[1] * x0[1]) + (x0[2] * x0[2] + x0[3] * x0[3]) + (x1[0] * x1[0] + x1[1] * x1[1]) + (x1[2] * x1[2] + x1[3] * x1[3]);
                        const f32x4 y0 = x0 * gs[bj][0], y1 = x1 * gs[bj][1];
                        u32x4 w; w.x = cvt_pk(y0[0], y0[1]); w.y = cvt_pk(y0[2], y0[3]); w.z = cvt_pk(y1[0], y1[1]); w.w = cvt_pk(y1[2], y1[3]);
                        *(u32x4*)(xs + off + bj * 128) = w;
                    }
                }
                if (wxs) { ss += __shfl_xor(ss, 16); ss += __shfl_xor(ss, 32); if (fq == 0) ssq[(size_t)row * 16 + u.pn * 4 + wc] = ss; }
            }
    }
};
template <int ACT> struct EpiLin {
    const float* ssq; const float* bias; int bstride; bf16_t* out; int ldc; int rowbase;
    __device__ __forceinline__ void operator()(f32x4 (&acc)[2][2][4][2], const Unit& u, int wr, int wc, int fr, int fq) const {
        const int mi = mi_of_tile(u.pm);
        const int col = u.pn * 256 + wc * 32 + 8 * fq;
        f32x4 bv[2][2];
#pragma unroll
        for (int bj = 0; bj < 2; ++bj)
#pragma unroll
            for (int n = 0; n < 2; ++n) bv[bj][n] = *(const f32x4*)(bias + (size_t)mi * bstride + col + bj * 128 + 4 * n);
#pragma unroll
        for (int ai = 0; ai < 2; ++ai)
#pragma unroll
            for (int m = 0; m < 4; ++m) {
                const int row = u.pm * 256 + ai * 128 + wr * 64 + m * 16 + fr;
                const float rs = row_rstd(ssq, row);
                bf16_t* op = out + (size_t)(row - rowbase) * ldc + col;
#pragma unroll
                for (int bj = 0; bj < 2; ++bj) {
                    f32x4 v0 = acc[ai][bj][m][0] * rs + bv[bj][0], v1 = acc[ai][bj][m][1] * rs + bv[bj][1];
                    if (ACT == 1) {
#pragma unroll
                        for (int j = 0; j < 4; ++j) { v0[j] = fast_sigmoid(v0[j]); v1[j] = fast_sigmoid(v1[j]); }
                    }
                    u32x4 w; w.x = cvt_pk(v0[0], v0[1]); w.y = cvt_pk(v0[2], v0[3]); w.z = cvt_pk(v1[0], v1[1]); w.w = cvt_pk(v1[2], v1[3]);
                    *(u32x4*)(op + bj * 128) = w;
                }
            }
    }
};
struct EpiLru {
    const bf16_t* ybuf; const float* lc; unsigned* ab;
    __device__ __forceinline__ void operator()(f32x4 (&acc)[2][2][4][2], const Unit& u, int wr, int wc, int fr, int fq) const {
        const int dir = u.pn >> 1, ch0 = (u.pn & 1) * 128 + wc * 32 + 8 * fq;
        unsigned* A = ab + ((size_t)dir * MT) * 256;
        const float* lcp = lc + dir * 256 + ch0;
#pragma unroll
        for (int n = 0; n < 2; ++n) {
            const f32x4 ba = *(const f32x4*)(lcp + 4 * n), bx = *(const f32x4*)(lcp + 512 + 4 * n), sp = *(const f32x4*)(lcp + 1024 + 4 * n);
#pragma unroll
            for (int ai = 0; ai < 2; ++ai)
#pragma unroll
                for (int m = 0; m < 4; ++m) {
                    asm volatile("" : "+v"(acc[ai][0][m][n]), "+v"(acc[ai][1][m][n]) :: "memory");
                    const int row = u.pm * 256 + ai * 128 + wr * 64 + m * 16 + fr;
                    const u32x2 uw = *(const u32x2*)(ybuf + (size_t)row * D + 512 + ch0 + 4 * n);
                    const float uf[4] = {bflo(uw.x), bfhi(uw.x), bflo(uw.y), bfhi(uw.y)};
                    u32x4 o;
#pragma unroll
                    for (int j = 0; j < 4; ++j) {
                        const float r = fast_sigmoid(acc[ai][0][m][n][j] + ba[j]), ig = fast_sigmoid(acc[ai][1][m][n][j] + bx[j]);
                        const float la = sp[j] * r, x = 2.0f * la;
                        float em2 = -x * (1.0f + x * (0.5f + x * (0.16666667f + x * (0.041666668f + x * 0.0083333338f))));
                        float em1 = -la * (1.0f + la * (0.5f + la * (0.16666667f + la * (0.041666668f + la * 0.0083333338f))));
                        if (x < -0.25f) { em2 = 1.0f - __expf(x); em1 = 1.0f - __expf(la); }
                        o[j] = cvt_pk(em1, __builtin_amdgcn_sqrtf(em2) * ig * uf[j]);
                    }
                    *(u32x4*)(A + (size_t)row * 256 + ch0 + 4 * n) = o;
                }
        }
    }
};
struct EpiBranch {
    const bf16_t* gl; int rowbase; bf16_t* out;
    __device__ __forceinline__ void operator()(f32x4 (&acc)[2][2][4][2], const Unit& u, int wr, int wc, int fr, int fq) const {
        const int col = u.pn * 128 + wc * 32 + 8 * fq, b = u.aux;
#pragma unroll
        for (int ai = 0; ai < 2; ++ai)
#pragma unroll
            for (int m = 0; m < 4; ++m) {
                const int row = u.pm * 256 + ai * 128 + wr * 64 + m * 16 + fr;
                const u32x4 gw = *(const u32x4*)(gl + (size_t)(row - rowbase) * 4096 + b * 1024 + col);
                f32x4 g0 = {bflo(gw.x), bfhi(gw.x), bflo(gw.y), bfhi(gw.y)}, g1 = {bflo(gw.z), bfhi(gw.z), bflo(gw.w), bfhi(gw.w)};
                acc[ai][1][m][0] += g0 * acc[ai][0][m][0]; acc[ai][1][m][1] += g1 * acc[ai][0][m][1];
                if (b == 3) {
                    const f32x4 v0 = acc[ai][1][m][0], v1 = acc[ai][1][m][1];
                    u32x4 w; w.x = cvt_pk(v0[0], v0[1]); w.y = cvt_pk(v0[2], v0[3]); w.z = cvt_pk(v1[0], v1[1]); w.w = cvt_pk(v1[2], v1[3]);
                    *(u32x4*)(out + (size_t)row * D + col) = w;
                    acc[ai][1][m][0] = (f32x4){0.f, 0.f, 0.f, 0.f}; acc[ai][1][m][1] = (f32x4){0.f, 0.f, 0.f, 0.f};
                }
            }
    }
};
}

__device__ __forceinline__ void unpack8(const u32x4 w, float* f) { f[0] = bflo(w.x); f[1] = bfhi(w.x); f[2] = bflo(w.y); f[3] = bfhi(w.y); f[4] = bflo(w.z); f[5] = bfhi(w.z); f[6] = bflo(w.w); f[7] = bfhi(w.w); }
__device__ __forceinline__ bf16x8 pack8(const float* f) { u32x4 w; w.x = cvt_pk(f[0], f[1]); w.y = cvt_pk(f[2], f[3]); w.z = cvt_pk(f[4], f[5]); w.w = cvt_pk(f[6], f[7]); return __builtin_bit_cast(bf16x8, w); }

template <bool NA>
__device__ __forceinline__ void attn_load_raw(u32x4 (&rk)[NA ? 4 : 2], u32x4 (&rv)[NA ? 4 : 2], const bf16_t* um, size_t krow0, int tid) {
    if (NA) {
        const int krow = tid >> 1, key = krow >> 2, hd = krow & 3, part = tid & 1;
        const bf16_t* p = um + (krow0 + key) * NMIX + 2048 + hd * 64 + part * 32;
#pragma unroll
        for (int i = 0; i < (NA ? 4 : 2); ++i) rk[i] = *(const u32x4*)(p + 8 * i);
    } else {
        const int krow = tid >> 2, key = krow >> 1, kvh = krow & 1, part = tid & 3;
        const bf16_t* p = um + (krow0 + key) * NMIX + 1024 + kvh * 64 + part * 16;
        rk[0] = *(const u32x4*)(p); rk[1] = *(const u32x4*)(p + 8);
    }
#pragma unroll
    for (int i = 0; i < (NA ? 4 : 2); ++i) { const int pc = i * 512 + tid, hdd = pc >> 3, part = pc & 7, hd = hdd >> 6, d = hdd & 63;
        rv[i] = *(const u32x4*)(um + (krow0 + d) * NMIX + (NA ? 2304 : 1152) + hd * 64 + part * 8); }
}
template <bool NA>
__device__ __forceinline__ void attn_store_chunk(const u32x4 (&rk)[NA ? 4 : 2], const u32x4 (&rv)[NA ? 4 : 2], LAS bf16_t* Kl, LAS bf16_t* Vt, int tid) {
    if (NA) {
        const int krow = tid >> 1, key = krow >> 2, hd = krow & 3, part = tid & 1;
        LAS bf16_t* dst = Kl + (hd * 64 + key) * 72 + part * 32;
#pragma unroll
        for (int i = 0; i < (NA ? 4 : 2); ++i) *(LAS u32x4*)(dst + 8 * i) = rk[i];
    } else {
        const int krow = tid >> 2, key = krow >> 1, kvh = krow & 1, part = tid & 3;
        LAS bf16_t* dst = Kl + (kvh * 64 + key) * 72 + part * 16;
        *(LAS u32x4*)(dst) = rk[0]; *(LAS u32x4*)(dst + 8) = rk[1];
    }
#pragma unroll
    for (int i = 0; i < (NA ? 4 : 2); ++i) { const int pc = i * 512 + tid, hdd = pc >> 3, part = pc & 7;
        *(LAS u32x4*)(Vt + hdd * 72 + part * 8) = rv[i]; }
}

template <bool NA>
__device__ __forceinline__ void attn_unit(LAS unsigned char* lds, const bf16_t* um, bf16_t* y, const float* gq, const float* gk, const float* sinkp, const float* relb,
                                          const float* ropeC, const float* ropeS, int b, int tb, bool qctx, const int tid) {
    const int wid = __builtin_amdgcn_readfirstlane(tid >> 6), lane = tid & 63, ql = lane & 31, hh = lane >> 5;
    const int h = wid >> 1, qs = wid & 1;
    constexpr int QC = NA ? 1792 : 768, YC = NA ? 768 : 256;
    constexpr float QSCALE = 0.125f * LOG2E;
    LAS bf16_t* Kl = (LAS bf16_t*)lds;
    LAS bf16_t* Vt = (LAS bf16_t*)(lds + 36864);
    LAS float* btab = (LAS float*)(lds + 73728);
    const int qi = qs * 32 + ql;
    const int qtok = tb * 64 + qi;
    const size_t qrow = qctx ? (size_t)ML + b * CTXL + qtok : (size_t)b * SEQ + qtok;
    __syncthreads();
    float bmax = 0.f;
    if (NA) {
#pragma unroll
        for (int w = 0; w < 8; ++w) bmax = fmaxf(bmax, btab[7620 + 112 + w]); }
    bf16x8 qp[4], qr[4]; float mq, qn2 = 0.f;
    {
        float qf[4][8]; float ss = 0.f;
#pragma unroll
        for (int s = 0; s < 4; ++s) { const u32x4 w = *(const u32x4*)(um + qrow * NMIX + QC + h * 64 + 16 * s + 8 * hh); unpack8(w, qf[s]);
#pragma unroll
            for (int j = 0; j < 8; ++j) ss += qf[s][j] * qf[s][j]; }
        ss += __shfl_xor(ss, 32);
        const float rs = rsqrtf(ss * (1.0f / 64.0f) + EPS) * QSCALE;
#pragma unroll
        for (int s = 0; s < 4; ++s) {
#pragma unroll
            for (int j = 0; j < 8; ++j) qf[s][j] *= rs * gq[16 * s + 8 * hh + j] * (NA ? gk[16 * s + 8 * hh + j] : 1.0f);
            qp[s] = pack8(qf[s]);
#pragma unroll
            for (int j = 0; j < 8; ++j) qn2 += qf[s][j] * qf[s][j];
        }
        qn2 += __shfl_xor(qn2, 32);
        if (!NA) {
            const int prow = qtok >> 6, pcol = qtok & 63;
            float r0[8], r1[8], r2[8], r3[8];
#pragma unroll
            for (int j = 0; j < 8; ++j) {
                const int i = 8 * hh + j;
                const float c0 = ropeC[prow * 16 + i], s0 = ropeS[prow * 16 + i], c1 = ropeC[pcol * 16 + i], s1 = ropeS[pcol * 16 + i];
                r0[j] = qf[0][j] * c0 - qf[1][j] * s0; r1[j] = qf[0][j] * s0 + qf[1][j] * c0;
                r2[j] = qf[2][j] * c1 - qf[3][j] * s1; r3[j] = qf[2][j] * s1 + qf[3][j] * c1;
            }
            qr[0] = pack8(r0); qr[1] = pack8(r1); qr[2] = pack8(r2); qr[3] = pack8(r3);
        } else { qr[0] = qp[0]; qr[1] = qp[1]; qr[2] = qp[2]; qr[3] = qp[3]; }
    }
    int kb0, nband;
    if (qctx) { kb0 = 0; nband = 0; }
    else if (NA) { kb0 = tb - 4; kb0 = kb0 < 0 ? 0 : (kb0 > 248 ? 248 : kb0); nband = 8; }
    else { kb0 = tb - 2 < 0 ? 0 : tb - 2; const int kb1 = tb + 2 > 255 ? 255 : tb + 2; nband = kb1 - kb0 + 1; }
    const int nch = 4 + nband;
    float lrun;
    { float kmax = 8.0f;
      if (!NA) { float g = 0.f;
#pragma unroll 8
          for (int d = 0; d < 64; ++d) g = fmaxf(g, fabsf(gk[d]));
          kmax *= g; }
      mq = sqrtf(qn2) * kmax + (NA ? bmax : 0.f) + 1e-3f;
      if (!NA) { const float sk = sinkp[h] * LOG2E; mq = fmaxf(mq, sk); lrun = hh == 0 ? __builtin_amdgcn_exp2f(sk - mq) : 0.f; } else lrun = 0.f; }
    f32x16 O0, O1;
#pragma unroll
    for (int i = 0; i < 16; ++i) { O0[i] = 0.f; O1[i] = 0.f; }
    const int kh = NA ? h : (h >> 1);
    u32x4 rk[NA ? 4 : 2], rv[NA ? 4 : 2];
    attn_load_raw<NA>(rk, rv, um, (size_t)ML + b * CTXL, tid);
    for (int ci = 0; ci < nch; ++ci) {
        const bool band = ci >= 4;
        const int kb = band ? kb0 + (ci - 4) : ci;
        int hh_o = hh, qi_o = qi, tid_o = tid; asm volatile("" : "+v"(hh_o), "+v"(qi_o), "+v"(tid_o) :: "memory");
        __syncthreads();
        attn_store_chunk<NA>(rk, rv, Kl, Vt, tid_o);
        if (ci + 1 < nch) { const int nb = (ci + 1 >= 4) ? kb0 + (ci + 1 - 4) : ci + 1; const size_t r0 = (ci + 1 >= 4) ? (size_t)b * SEQ + nb * 64 : (size_t)ML + b * CTXL + nb * 64; attn_load_raw<NA>(rk, rv, um, r0, tid_o); }
        asm volatile("s_waitcnt lgkmcnt(0)" ::: "memory"); __builtin_amdgcn_s_barrier(); asm volatile("" ::: "memory");
        f32x16 S0, S1;
#pragma unroll
        for (int i = 0; i < 16; ++i) { S0[i] = 0.f; S1[i] = 0.f; }
        const LAS bf16_t* kp = Kl + (kh * 64 + ql) * 72 + 8 * hh;
        const bool rot = band && !NA;
#pragma unroll
        for (int s = 0; s < 4; ++s) {
            const bf16x8 a0 = *(const LAS bf16x8*)(kp + 16 * s), a1 = *(const LAS bf16x8*)(kp + 32 * 72 + 16 * s);
            const bf16x8 q = rot ? qr[s] : qp[s];
            S0 = __builtin_amdgcn_mfma_f32_32x32x16_bf16(a0, q, S0, 0, 0, 0);
            S1 = __builtin_amdgcn_mfma_f32_32x32x16_bf16(a1, q, S1, 0, 0, 0);
        }
        if (band) {
            if (NA) {
                int cs = qi_o - 8; cs = cs < 0 ? 0 : (cs > 48 ? 48 : cs);
                const LAS float* tb_ = btab + (h * 15 + (kb - tb + 7)) * 127 + 4 * hh_o - qi_o + 63;
                const LAS float* tv_ = btab + 7620 + 4 * hh_o - cs + 48;
#pragma unroll
                for (int r = 0; r < 16; ++r) {
                    const int c0 = (r & 3) + 8 * (r >> 2);
                    S0[r] += tb_[c0] + tv_[c0];
                    S1[r] += tb_[c0 + 32] + tv_[c0 + 32];
                }
            } else {
                const int dk = kb - tb;
                if (dk == -2) {
#pragma unroll
                    for (int r = 0; r < 16; ++r) { const int k0 = (r & 3) + 8 * (r >> 2) + 4 * hh_o; if (k0 < qi_o) S0[r] = -1e30f; if (k0 + 32 < qi_o) S1[r] = -1e30f; }
                } else if (dk == 2) {
#pragma unroll
                    for (int r = 0; r < 16; ++r) { const int k0 = (r & 3) + 8 * (r >> 2) + 4 * hh_o; if (k0 > qi_o) S0[r] = -1e30f; if (k0 + 32 > qi_o) S1[r] = -1e30f; }
                }
            }
        }
        float ls = 0.f;
#pragma unroll
        for (int r = 0; r < 16; ++r) { S0[r] = __builtin_amdgcn_exp2f(S0[r] - mq); S1[r] = __builtin_amdgcn_exp2f(S1[r] - mq); ls += S0[r] + S1[r]; }
        lrun += ls;
        bf16x8 pf[2][2];
        { float t[8];
#pragma unroll
          for (int s2 = 0; s2 < 2; ++s2) {
#pragma unroll
              for (int j = 0; j < 8; ++j) t[j] = S0[8 * s2 + j];
              pf[0][s2] = pack8(t);
#pragma unroll
              for (int j = 0; j < 8; ++j) t[j] = S1[8 * s2 + j];
              pf[1][s2] = pack8(t);
          } }
        const LAS bf16_t* vp = Vt + (kh * 64 + ql) * 72 + 4 * hh;
#pragma unroll
        for (int kt = 0; kt < 2; ++kt)
#pragma unroll
            for (int s2 = 0; s2 < 2; ++s2) {
                const int base = 32 * kt + 16 * s2;
                { const u32x2 lo = *(const LAS u32x2*)(vp + base), hi = *(const LAS u32x2*)(vp + base + 8);
                  const u32x4 w = {lo.x, lo.y, hi.x, hi.y};
                  O0 = __builtin_amdgcn_mfma_f32_32x32x16_bf16(__builtin_bit_cast(bf16x8, w), pf[kt][s2], O0, 0, 0, 0); }
                { const u32x2 lo = *(const LAS u32x2*)(vp + 32 * 72 + base), hi = *(const LAS u32x2*)(vp + 32 * 72 + base + 8);
                  const u32x4 w = {lo.x, lo.y, hi.x, hi.y};
                  O1 = __builtin_amdgcn_mfma_f32_32x32x16_bf16(__builtin_bit_cast(bf16x8, w), pf[kt][s2], O1, 0, 0, 0); }
            }
    }
    lrun += __shfl_xor(lrun, 32);
    const float inv = 1.0f / lrun;
    int lane_e = lane; asm volatile("" : "+v"(lane_e));
    const int qtok_e = tb * 64 + qs * 32 + (lane_e & 31);
    const size_t qrow_e = qctx ? (size_t)ML + b * CTXL + qtok_e : (size_t)b * SEQ + qtok_e;
    bf16_t* yp = y + qrow_e * D + YC + h * 64 + 4 * (lane_e >> 5);
#pragma unroll
    for (int g4 = 0; g4 < 4; ++g4) {
        u32x2 w0, w1;
        w0.x = cvt_pk(O0[4 * g4] * inv, O0[4 * g4 + 1] * inv); w0.y = cvt_pk(O0[4 * g4 + 2] * inv, O0[4 * g4 + 3] * inv);
        w1.x = cvt_pk(O1[4 * g4] * inv, O1[4 * g4 + 1] * inv); w1.y = cvt_pk(O1[4 * g4 + 2] * inv, O1[4 * g4 + 3] * inv);
        *(u32x2*)(yp + 8 * g4) = w0; *(u32x2*)(yp + 32 + 8 * g4) = w1;
    }
}

__device__ __forceinline__ unsigned f2bf(float f) { unsigned u = __float_as_uint(f); return (u + 0x7fffu + ((u >> 16) & 1u)) >> 16; }
__device__ __forceinline__ unsigned pk2(float lo, float hi) { return f2bf(lo) | (f2bf(hi) << 16); }

__device__ __forceinline__ void transpose_item(const float* W, int K, int N, bf16_t* WT, int k0, int n0, int drow0, LAS float* scr, int lane) {
#pragma unroll
    for (int i = 0; i < 8; ++i) { const int kk = 8 * i + (lane >> 3), c4 = (lane & 7) * 4; const f32x4 v = *(const f32x4*)(W + (size_t)(k0 + kk) * N + n0 + c4);
        LAS float* d = scr + kk * 33 + c4; d[0] = v.x; d[1] = v.y; d[2] = v.z; d[3] = v.w; }
    asm volatile("s_waitcnt lgkmcnt(0)" ::: "memory");
    const int c = lane & 7;
#pragma unroll
    for (int j = 0; j < 4; ++j) { const int n = (lane >> 3) + 8 * j; const LAS float* s = scr + (8 * c) * 33 + n;
        u32x4 o; o.x = pk2(s[0 * 33], s[1 * 33]); o.y = pk2(s[2 * 33], s[3 * 33]); o.z = pk2(s[4 * 33], s[5 * 33]); o.w = pk2(s[6 * 33], s[7 * 33]);
        *(u32x4*)(WT + (size_t)(drow0 + n) * K + k0 + 8 * c) = o; }
    asm volatile("s_waitcnt lgkmcnt(0)" ::: "memory");
}
__device__ __forceinline__ float gelu_tanh(float x) {
    const float t = 0.7978845608028654f * (x + 0.044715f * x * x * x);
    const float e = __expf(2.0f * t);
    const float th = 1.0f - 2.0f * __builtin_amdgcn_rcpf(e + 1.0f);
    return 0.5f * x * (1.0f + th);
}


__device__ __forceinline__ void ctx_combine(const float* part, const float* xin, float* xout, const float* gate, const float* gs, bf16_t* xs, float* ssq, int gw, int NGW, int lane) {
    for (int r = gw; r < MC; r += NGW) {
        float ss = 0.f;
#pragma unroll
        for (int j = 0; j < 4; ++j) {
            const int col = 4 * lane + 256 * j;
            f32x4 sum = *(const f32x4*)(part + (size_t)r * D + col);
#pragma unroll
            for (int ks = 1; ks < 11; ++ks) sum += *(const f32x4*)(part + ((size_t)ks * MC + r) * D + col);
            const f32x4 x = *(const f32x4*)(xin + (size_t)r * D + col) + *(const f32x4*)(gate + col) * sum;
            *(f32x4*)(xout + (size_t)r * D + col) = x;
            ss += (x.x * x.x + x.y * x.y) + (x.z * x.z + x.w * x.w);
            const f32x4 g = *(const f32x4*)(gs + col);
            u32x2 w; w.x = cvt_pk(x.x * g.x, x.y * g.y); w.y = cvt_pk(x.z * g.z, x.w * g.w);
            *(u32x2*)(xs + (size_t)(ML + r) * D + col) = w;
        }
        ss = wave_sum(ss);
        if (lane < 16) ssq[(size_t)(ML + r) * 16 + lane] = lane == 0 ? ss : 0.f;
    }
}

#define XB_TMO      128
#define XB_XCNT(j)  (256  + 64 * (j))
#define XB_XSUB(j)  (1280 + 64 * (j))
#define XB_XGEN(j)  (2304 + 64 * (j))
#define XB_TOP      3328
#define XB_TOPGEN   3392
#define XB_SPIN_CAP (1u << 18)
__device__ __forceinline__ unsigned xb_ld(unsigned* p)              { return __hip_atomic_load(p, __ATOMIC_RELAXED, __HIP_MEMORY_SCOPE_AGENT); }
__device__ __forceinline__ unsigned xb_add(unsigned* p, unsigned v) { return __hip_atomic_fetch_add(p, v, __ATOMIC_RELAXED, __HIP_MEMORY_SCOPE_AGENT); }
__device__ __forceinline__ unsigned xb_xcc_id() { return (unsigned)__builtin_amdgcn_s_getreg((3 << 11) | 20) & 0xFu; }
#define XB_SPIN(cond, bar) do { unsigned _sp = 0; while (cond) { __builtin_amdgcn_s_sleep(1); \
    if ((++_sp & 255u) == 0u) { if (xb_ld(&(bar)[XB_TMO])) break; if (_sp > XB_SPIN_CAP) { atomicAdd(&(bar)[XB_TMO], 1u); break; } } } } while (0)
__device__ __forceinline__ void xcd_barrier_complete(unsigned* bar, unsigned x, unsigned& nloc, unsigned& nx) {
    const unsigned G = gridDim.x * gridDim.y * gridDim.z;
    unsigned sum, cnt, mine, sp = 0u;
    for (;;) {
        sum = 0u; cnt = 0u; mine = 0u;
#pragma unroll
        for (unsigned j = 0; j < 16; ++j) { const unsigned c = xb_ld(&bar[XB_XCNT(j)]); sum += c; cnt += (c > 0u) ? 1u : 0u; mine = (j == x) ? c : mine; }
        if (sum == G) break;
        __builtin_amdgcn_s_sleep(1);
        if ((++sp & 255u) == 0u) { if (xb_ld(&bar[XB_TMO])) break; if (sp > XB_SPIN_CAP) { atomicAdd(&bar[XB_TMO], 1u); break; } }
    }
    nloc = mine > 0u ? mine : 1u; nx = cnt > 0u ? cnt : 1u;
}
__device__ __forceinline__ void xcd_barrier(unsigned* bar, volatile LAS unsigned* st, int tid) {
    asm volatile("s_waitcnt vmcnt(0)" ::: "memory");
    __syncthreads();
    if (tid == 0) {
        const unsigned x = xb_xcc_id();
        __builtin_amdgcn_s_waitcnt(0);
        unsigned nloc = st[0], nx = st[1];
        if (nloc == 0u) { xcd_barrier_complete(bar, x, nloc, nx); st[0] = nloc; st[1] = nx; }
        const unsigned old = xb_add(&bar[XB_XSUB(x)], 1u);
        const unsigned gen = old / nloc;
        if (old + 1u == (gen + 1u) * nloc) {
            __builtin_amdgcn_fence(__ATOMIC_RELEASE, "agent");
            asm volatile("s_waitcnt vmcnt(0)" ::: "memory");
            const unsigned og = xb_add(&bar[XB_TOP], 1u);
            const unsigned tg = og / nx;
            if (og + 1u == (tg + 1u) * nx) xb_add(&bar[XB_TOPGEN], 1u);
            else XB_SPIN(xb_ld(&bar[XB_TOPGEN]) == tg, bar);
            __builtin_amdgcn_fence(__ATOMIC_ACQUIRE, "agent");
            xb_add(&bar[XB_XGEN(x)], 1u);
            asm volatile("s_waitcnt vmcnt(0)" ::: "memory");
        } else {
            XB_SPIN(xb_ld(&bar[XB_XGEN(x)]) == gen, bar);
            __builtin_amdgcn_fence(__ATOMIC_ACQUIRE, "agent");
            asm volatile("s_waitcnt vmcnt(0)" ::: "memory");
        }
    }
    __syncthreads();
}
constexpr int LDS_BAR_OFF = 139264;

enum { K_CONV = 0, K_PREP, K_FFN_UP0, K_FFN_DN0, K_WIN_A, K_KVPREP, K_MIX, K_LRU_GEMM, K_LRU_SUM, K_LRU_FIN, K_WIN_B0, K_BR0, K_WIN_B1, K_BR1, K_WOUT, K_FFN_UP1, K_FFN_DN1, K_PER_LAYER };
constexpr int N_STEPS = 2 * K_PER_LAYER;

template <int KM> __global__ void __launch_bounds__(512, 2) fwd_mega_t(Params P) {
    extern __shared__ __attribute__((aligned(16))) unsigned char lds_raw[];
    LAS unsigned char* lds = (LAS unsigned char*)lds_raw;
    cg::grid_group grid = cg::this_grid();
    const int wave_k = __builtin_amdgcn_readfirstlane(threadIdx.x >> 6);
    if (P.hi - P.lo > 1) {
        volatile LAS unsigned* st0 = (volatile LAS unsigned*)(lds + LDS_BAR_OFF);
        if (threadIdx.x == 0) { st0[0] = 0u; st0[1] = 0u; (void)xb_add(&((unsigned*)P.ws)[XB_XCNT(xb_xcc_id())], 1u); }
        __syncthreads();
    }

    for (int step = P.lo; step < P.hi; ++step)
    for (int rep = 0; rep < (int)((((unsigned)DBL_MASK) >> (step % K_PER_LAYER)) & 1u) + 1; ++rep) {
        const char __attribute__((address_space(4)))* ka = (const char __attribute__((address_space(4)))*)__builtin_amdgcn_kernarg_segment_ptr();
        asm volatile("" : "+s"(ka));
        int G = gridDim.x, bid = blockIdx.x, wave = wave_k;
        asm volatile("" : "+s"(wave), "+s"(G), "+s"(bid));
        int lane = (int)__builtin_amdgcn_mbcnt_hi(~0u, __builtin_amdgcn_mbcnt_lo(~0u, 0u));
        asm volatile("" : "+v"(lane));
        const int tid = wave * 64 + lane;
#define PIN(i) (*(const float* const __attribute__((address_space(4)))*)(ka + 8 * (i)))
        float* const Pout = *(float* const __attribute__((address_space(4)))*)(ka + 200);
        unsigned char* const ws = *(unsigned char* const __attribute__((address_space(4)))*)(ka + 208);
        float* mod = (float*)(ws + OFF_MOD); float* GS = (float*)(ws + OFF_GS); float* BIAS = (float*)(ws + OFF_BIAS);
        float* ropeC = (float*)(ws + OFF_ROPE); float* ropeS = ropeC + 256 * 16; float* LRUC = (float*)(ws + OFF_LRUC);
        f32x2* SUM = (f32x2*)(ws + OFF_SUM); float* SSQ = (float*)(ws + OFF_SSQ); float* XC = (float*)(ws + OFF_XC);
        bf16_t* W1A = (bf16_t*)(ws + W_W1A); bf16_t* WDA = (bf16_t*)(ws + W_WDA); bf16_t* WIN = (bf16_t*)(ws + W_WIN); bf16_t* WBR = (bf16_t*)(ws + W_WBR);
        bf16_t* WOUT = (bf16_t*)(ws + W_WOUT); bf16_t* W1B = (bf16_t*)(ws + W_W1B); bf16_t* WDB = (bf16_t*)(ws + W_WDB); bf16_t* WLRU = (bf16_t*)(ws + W_WLRU);
        bf16_t* XA = (bf16_t*)(ws + OFF_XA); bf16_t* XB = (bf16_t*)(ws + OFF_XB); bf16_t* ACT = (bf16_t*)(ws + OFF_R); bf16_t* UM = (bf16_t*)(ws + OFF_R);
        bf16_t* GL = (bf16_t*)(ws + OFF_GL); float* AB = (float*)(ws + OFF_GL); float* PART = (float*)(ws + OFF_PART);
        float* sW1a = BIAS; float* sWin = BIAS + 3 * 5632; float* sW1b = sWin + 3 * INW;
        const int l = step / K_PER_LAYER, kind = step % K_PER_LAYER;
        const bool ctx_out = (l == 0);
        const int nMall = ctx_out ? 130 : 128;
        const float* modl = mod + (size_t)l * 3 * NMOD;
        __syncthreads();
        switch (kind) {
        case K_CONV: if (EN(K_CONV)) {
            if (l == 1)
                ctx_combine(PART, XC, XC, mod + 8 * 1024 + 2 * NMOD, GS + (((size_t)1 * 3 + 0) * 3 + 2) * 1024, XA, SSQ, bid * 8 + wave, G * 8, lane);
            LAS float* scr = (LAS float*)(lds + wave * 8448);
            if (l == 0) {
                LAS float* sc = (LAS float*)(lds + 69632);
                LAS float* red = (LAS float*)(lds + 69632 + 12288);
                for (int i = tid; i < 3 * 1024; i += 512) { const int mi = i >> 10, k = i & 1023; const float v = mi < 2 ? PIN(1)[mi * 1024 + k] : PIN(3)[k]; sc[i] = v * fast_sigmoid(v); }
                __syncthreads();
                for (int it = bid; it < 2 * 144; it += G) {
                    const int ll = it / 144, n = (it % 144) * 64 + lane;
                    const float* wm = PIN(4) + (size_t)ll * 1024 * NMOD + n;
                    float a0 = 0.f, a1 = 0.f, a2 = 0.f;
#pragma unroll 8
                    for (int k = wave * 128; k < wave * 128 + 128; ++k) { const float w = wm[(size_t)k * NMOD]; a0 += sc[k] * w; a1 += sc[1024 + k] * w; a2 += sc[2048 + k] * w; }
                    red[(wave * 3 + 0) * 64 + lane] = a0; red[(wave * 3 + 1) * 64 + lane] = a1; red[(wave * 3 + 2) * 64 + lane] = a2;
                    __syncthreads();
                    if (tid < 192) {
                        const int mi = tid >> 6; float s = 0.f;
#pragma unroll
                        for (int w = 0; w < 8; ++w) s += red[(w * 3 + mi) * 64 + lane];
                        s += PIN(5)[ll * NMOD + n];
                        const int j = n >> 10, col = n & 1023;
                        mod[((size_t)ll * 3 + mi) * NMOD + n] = (j == 2 || j == 8) ? 0.5f * s : s;
                        if (j == 1 || j == 4 || j == 7) { const int sidx = j / 3; GS[(((size_t)ll * 3 + sidx) * 3 + mi) * 1024 + col] = PIN(6)[((size_t)ll * 3 + sidx) * 1024 + col] * (1.0f + s); }
                    }
                    __syncthreads();
                }
                for (int i = bid * 512 + tid; i < 256 * 16; i += G * 512) { const int pos = i >> 4, f = i & 15; const float inv = powf(10000.0f, -(float)f / 16.0f); float s, c; sincosf((float)pos * inv, &s, &c); ropeC[i] = c; ropeS[i] = s; }
            }
            const int gw = bid * 8 + wave, NGW = G * 8;
            const float* fg = PIN(7) + (size_t)l * 2 * D * DFF; const float* fu = PIN(8) + (size_t)l * 2 * D * DFF; const float* fd = PIN(9) + (size_t)l * 2 * DFF * D;
            const float* win = PIN(10) + (size_t)l * D * INW; const float* wbr = PIN(23) + (size_t)l * 4 * 256 * D; const float* wo = PIN(24) + (size_t)l * D * D;
            constexpr int I_GU = 16 * 88, I_DN = 44 * 32, I_IN = 16 * 208, I_BR = 4 * 32, I_O = 16 * 32;
            constexpr int NIT = 4 * I_GU + 2 * I_DN + I_IN + 4 * I_BR + I_O;
            for (int it = gw; it < NIT; it += NGW) {
                int r = it;
                if (r < 4 * I_GU) {
                    const int which = r / I_GU; r %= I_GU; const int kb = r / 88, nb = r % 88, n0 = nb * 32;
                    const float* src = ((which & 1) ? fu : fg) + (size_t)(which >> 1) * D * DFF;
                    transpose_item(src, D, DFF, (which >> 1) ? W1B : W1A, kb * 64, n0, (n0 >> 7) * 256 + (n0 & 127) + ((which & 1) ? 128 : 0), scr, lane); continue; }
                r -= 4 * I_GU;
                if (r < 2 * I_DN) { const int which = r / I_DN; r %= I_DN; const int kb = r / 32, nb = r % 32;
                    transpose_item(fd + (size_t)which * DFF * D, DFF, D, which ? WDB : WDA, kb * 64, nb * 32, nb * 32, scr, lane); continue; }
                r -= 2 * I_DN;
                if (r < I_IN) { const int kb = r / 208, nb = r % 208; transpose_item(win, D, INW, WIN, kb * 64, nb * 32, nb * 32, scr, lane); continue; }
                r -= I_IN;
                if (r < 4 * I_BR) { const int b = r / I_BR; r %= I_BR; const int kb = r / 32, nb = r % 32;
                    transpose_item(wbr + (size_t)b * 256 * D, 256, D, WBR + (size_t)b * 1024 * 256, kb * 64, nb * 32, nb * 32, scr, lane); continue; }
                r -= 4 * I_BR;
                { const int kb = r / 32, nb = r % 32; transpose_item(wo, D, D, WOUT, kb * 64, nb * 32, nb * 32, scr, lane); }
            }
            if (bid == 0) { const int i = tid; LRUC[i] = PIN(18)[(size_t)l * 512 + i]; LRUC[512 + i] = PIN(20)[(size_t)l * 512 + i]; LRUC[1024 + i] = -8.0f * log1pf(__expf(-PIN(21)[(size_t)l * 512 + i])); }
            const float* wa = PIN(17) + (size_t)l * 2 * 4 * 64 * 64; const float* wx = PIN(19) + (size_t)l * 2 * 4 * 64 * 64;
            for (int i = bid * 512 + tid; i < 1024 * 32; i += G * 512) {
                const int row = i >> 5, k0 = (i & 31) * 8;
                const int pn = row >> 8, within = row & 255, typ = within >> 7, ch = (pn & 1) * 128 + (within & 127), dir = pn >> 1, nblk = ch >> 6, e = ch & 63;
                const float* src = (typ ? wx : wa) + ((size_t)(dir * 4 + nblk) * 64) * 64 + e;
                float v[8];
#pragma unroll
                for (int j = 0; j < 8; ++j) { const int k = k0 + j; v[j] = ((k >> 6) == nblk) ? src[(size_t)(k & 63) * 64] : 0.f; }
                u32x4 o; o.x = pk2(v[0], v[1]); o.y = pk2(v[2], v[3]); o.z = pk2(v[4], v[5]); o.w = pk2(v[6], v[7]);
                *(u32x4*)(WLRU + (size_t)row * 256 + k0) = o;
            }
        } break;
        case K_PREP: if (EN(K_PREP)) {
            const int gw = bid * 8 + wave, NGW = G * 8;
            for (int r = gw; r < 5632 + INW + 5632; r += NGW) {
                const bf16_t* wrow; int sidx; float* dst; int dstride; int rr = r; float extra = 0.f;
                if (rr < 5632) { wrow = W1A + (size_t)rr * D; sidx = 0; dst = sW1a + rr; dstride = 5632; }
                else if (rr < 5632 + INW) { rr -= 5632; wrow = WIN + (size_t)rr * D; sidx = 3; dst = sWin + rr; dstride = INW; if (rr >= NMIX) extra = PIN(11)[(size_t)l * 4096 + rr - NMIX]; }
                else { rr -= 5632 + INW; wrow = W1B + (size_t)rr * D; sidx = 6; dst = sW1b + rr; dstride = 5632; }
                float a0 = 0.f, a1 = 0.f, a2 = 0.f;
#pragma unroll
                for (int hf = 0; hf < 2; ++hf) {
                    const int k = hf * 512 + lane * 8; float wv[8]; unpack8(*(const u32x4*)(wrow + k), wv);
                    const float* s0 = modl + sidx * 1024 + k;
#pragma unroll
                    for (int j = 0; j < 8; ++j) { a0 += wv[j] * s0[j]; a1 += wv[j] * s0[NMOD + j]; a2 += wv[j] * s0[2 * NMOD + j]; }
                }
                a0 = wave_sum(a0); a1 = wave_sum(a1); a2 = wave_sum(a2);
                if (lane == 0) { dst[0] = a0 + extra; dst[dstride] = a1 + extra; dst[2 * dstride] = a2 + extra; }
            }
            if (l == 0) {
                for (int row = gw; row < MT; row += NGW) {
                    const float* xr = row < ML ? PIN(0) + (size_t)row * D : PIN(2) + (size_t)(row - ML) * D;
                    const int mi = row < SEQ ? 0 : (row < ML ? 1 : 2);
                    const float* gs = GS + (size_t)mi * 1024;
                    float ss = 0.f;
#pragma unroll
                    for (int j = 0; j < 4; ++j) {
                        const f32x4 v = *(const f32x4*)(xr + 4 * lane + 256 * j), g = *(const f32x4*)(gs + 4 * lane + 256 * j);
                        ss += (v.x * v.x + v.y * v.y) + (v.z * v.z + v.w * v.w);
                        u32x2 w; w.x = cvt_pk(v.x * g.x, v.y * g.y); w.y = cvt_pk(v.z * g.z, v.w * g.w);
                        *(u32x2*)(XA + (size_t)row * D + 4 * lane + 256 * j) = w;
                    }
                    ss = wave_sum(ss);
                    if (lane < 16) SSQ[(size_t)row * 16 + lane] = lane == 0 ? ss : 0.f;
                }
            }
        } break;
        case K_FFN_UP0: case K_FFN_UP1: if (EN(K_FFN_UP0)) {
            const bool second = kind == K_FFN_UP1;
            const int nM = second ? nMall : 130;
            pg8::SchedStd S; S.init(0, nM, 22, G, bid, second ? XB : XA, D, second ? W1B : W1A, D, D);
            pg8::EpiSwiGLU E{SSQ, second ? sW1b : sW1a, ACT};
            pg8::gemm_phase<pg8::EpiSwiGLU, pg8::SchedStd, 2>(lds, tid, D, D, D, S, E);
        } break;
        case K_FFN_DN0: case K_FFN_DN1: case K_WOUT: if (EN(K_FFN_DN0)) {
            const bool first_in = (l == 0 && kind == K_FFN_DN0);
            const bool last_out = (l == 1 && kind == K_FFN_DN1);
            const int nM = (kind == K_FFN_DN0) ? 130 : nMall;
            const bf16_t* A = (kind == K_WOUT) ? XA : ACT; const bf16_t* Bt = (kind == K_WOUT) ? WOUT : (kind == K_FFN_DN0 ? WDA : WDB);
            const int K = (kind == K_WOUT) ? D : DFF;
            const int gidx = (kind == K_FFN_DN0) ? 2 : (kind == K_WOUT ? 5 : 8);
            const int gsidx = (kind == K_FFN_DN0) ? l * 3 + 1 : (kind == K_WOUT ? l * 3 + 2 : (last_out ? 0 : l * 3 + 3));
            const float* gsn = GS + (size_t)gsidx * 3072;
            bf16_t* xs = (kind == K_WOUT) ? XB : XA;
            const bool split_ctx = (kind != K_WOUT) && (nM == 130);
            pg8::SchedDn S; S.std.init(0, split_ctx ? 128 : nM, 4, G, bid, A, K, Bt, K, K); S.nctx = split_ctx ? 88 : 0;
            pg8::EpiRes E{first_in ? PIN(0) : Pout, first_in ? PIN(2) : XC, Pout, XC, modl + gidx * 1024, gsn, xs, SSQ, PART, last_out ? 0 : 1};
            pg8::gemm_phase<pg8::EpiRes, pg8::SchedDn, 2>(lds, tid, K, K, K, S, E);
        } break;
        case K_WIN_A: if (EN(K_WIN_A)) {
            ctx_combine(PART, l == 0 ? PIN(2) : XC, XC, modl + 2 * 1024 + 2 * NMOD, GS + (((size_t)l * 3 + 1) * 3 + 2) * 1024, XA, SSQ, bid * 8 + wave, G * 8, lane);
            xcd_barrier((unsigned*)ws, (volatile LAS unsigned*)(lds + LDS_BAR_OFF), tid);
            pg8::SchedStd S; S.init(0, 130, 10, G, bid, XA, D, WIN, D, D);
            pg8::EpiLin<0> E{SSQ, sWin, INW, UM, NMIX, 0};
            pg8::gemm_phase<pg8::EpiLin<0>, pg8::SchedStd, 2>(lds, tid, D, D, D, S, E);
        } break;
        case K_WIN_B0: case K_WIN_B1: if (EN(K_WIN_B0)) {
            const int m0 = kind == K_WIN_B0 ? 0 : 64, nM = kind == K_WIN_B0 ? 64 : (nMall - 64);
            pg8::SchedStd S; S.init(m0, nM, 16, G, bid, XA, D, WIN + (size_t)NMIX * D, D, D);
            pg8::EpiLin<1> E{SSQ, sWin + NMIX, INW, GL, 4096, m0 * 256};
            pg8::gemm_phase<pg8::EpiLin<1>, pg8::SchedStd, 2>(lds, tid, D, D, D, S, E);
        } break;
        case K_BR0: case K_BR1: if (EN(K_BR0)) {
            const int m0 = kind == K_BR0 ? 0 : 64, nM = kind == K_BR0 ? 64 : (nMall - 64);
            pg8::SchedBr S{m0, nM, G, bid, (const char*)XB, (const char*)WBR};
            pg8::EpiBranch E{GL, m0 * 256, XA};
            pg8::gemm_phase<pg8::EpiBranch, pg8::SchedBr, 1>(lds, tid, 256, D, 256, S, E);
        } break;
        case K_LRU_GEMM: if (EN(K_LRU_GEMM)) {
            pg8::SchedStd S; S.init(0, 130, 4, G, bid, XB + 512, D, WLRU, 256, 256);
            pg8::EpiLru E{XB, LRUC, (unsigned*)AB};
            int Kq = 256; asm volatile("" : "+s"(Kq));
            pg8::gemm_phase<pg8::EpiLru, pg8::SchedStd, 2>(lds, tid, Kq, D, 256, S, E);
        } break;
        case K_KVPREP: if (EN(K_KVPREP)) {
            LAS bf16_t* Vt6 = (LAS bf16_t*)lds;
            const float* gkb = PIN(13) + (size_t)l * 256 + 64;
            for (int blk = bid; blk < 520; blk += G) {
                const bool lat = blk < 512;
                const size_t row0 = lat ? (size_t)blk * 64 : (size_t)ML + (blk - 512) * 64;
                const int tok0 = lat ? (blk & 255) * 64 : 0;
                __syncthreads();
                {
                    const int krow = tid >> 2, key = krow >> 1, kvh = krow & 1, part = tid & 3;
                    bf16_t* p = UM + (row0 + key) * NMIX + 1024 + kvh * 64 + part * 16;
                    float v[16]; unpack8(*(const u32x4*)(p), v); unpack8(*(const u32x4*)(p + 8), v + 8);
                    float ss = 0.f;
#pragma unroll
                    for (int e = 0; e < 16; ++e) ss += v[e] * v[e];
                    ss += __shfl_xor(ss, 1); ss += __shfl_xor(ss, 2);
                    const float rs = rsqrtf(ss * (1.0f / 64.0f) + EPS);
#pragma unroll
                    for (int e = 0; e < 16; ++e) v[e] *= rs * gkb[part * 16 + e];
                    if (lat) {
                        const int ktok = tok0 + key, pos = (part < 2) ? (ktok >> 6) : (ktok & 63);
#pragma unroll
                        for (int e = 0; e < 16; ++e) { const float pv = __shfl_xor(v[e], 1), c = ropeC[pos * 16 + e], sn = ropeS[pos * 16 + e]; v[e] = (part & 1) ? (pv * sn + v[e] * c) : (v[e] * c - pv * sn); }
                    }
                    *(bf16x8*)(p) = pack8(v); *(bf16x8*)(p + 8) = pack8(v + 8);
                }
                {
                    const int krow = tid >> 1, key = krow >> 2, hd = krow & 3, part = tid & 1;
                    bf16_t* p = UM + (row0 + key) * NMIX + 2048 + hd * 64 + part * 32;
                    float v[32];
#pragma unroll
                    for (int i = 0; i < 4; ++i) unpack8(*(const u32x4*)(p + 8 * i), v + 8 * i);
                    float ss = 0.f;
#pragma unroll
                    for (int e = 0; e < 32; ++e) ss += v[e] * v[e];
                    ss += __shfl_xor(ss, 1);
                    const float rs = rsqrtf(ss * (1.0f / 64.0f) + EPS);
#pragma unroll
                    for (int e = 0; e < 32; ++e) v[e] *= rs;
#pragma unroll
                    for (int i = 0; i < 4; ++i) *(bf16x8*)(p + 8 * i) = pack8(v + 8 * i);
                }
                {
                    const int key = tid >> 3, piece = tid & 7;
                    {
                        const u32x4 a = *(const u32x4*)(UM + (row0 + key) * NMIX + 1152 + piece * 16), b2 = *(const u32x4*)(UM + (row0 + key) * NMIX + 1152 + piece * 16 + 8);
                        const int hd = piece >> 2, d0 = (piece & 3) * 16;
                        LAS bf16_t* vd = Vt6 + (hd * 64 + d0) * 72 + key;
                        const unsigned w[8] = {a.x, a.y, a.z, a.w, b2.x, b2.y, b2.z, b2.w};
#pragma unroll
                        for (int q = 0; q < 8; ++q) { vd[(2 * q) * 72] = (bf16_t)(w[q] & 0xffffu); vd[(2 * q + 1) * 72] = (bf16_t)(w[q] >> 16); }
                    }
                    {
                        const bf16_t* q0 = UM + (row0 + key) * NMIX + 2304 + piece * 32;
                        const int hd = 2 + (piece >> 1), d0 = (piece & 1) * 32;
                        LAS bf16_t* vd = Vt6 + (hd * 64 + d0) * 72 + key;
#pragma unroll
                        for (int i = 0; i < 4; ++i) { const u32x4 a = *(const u32x4*)(q0 + 8 * i); const unsigned w[4] = {a.x, a.y, a.z, a.w};
#pragma unroll
                            for (int q = 0; q < 4; ++q) { vd[(8 * i + 2 * q) * 72] = (bf16_t)(w[q] & 0xffffu); vd[(8 * i + 2 * q + 1) * 72] = (bf16_t)(w[q] >> 16); } }
                    }
                    __syncthreads();
#pragma unroll
                    for (int i = 0; i < 6; ++i) { const int pc = i * 512 + tid, hdd = pc >> 3, part = pc & 7, hd6 = hdd >> 6, d = hdd & 63;
                        const u32x4 v = *(const LAS u32x4*)(Vt6 + hdd * 72 + part * 8);
                        *(u32x4*)(UM + (row0 + d) * NMIX + (hd6 < 2 ? 1152 + hd6 * 64 : 2304 + (hd6 - 2) * 64) + part * 8) = v; }
                }
            }
        } break;
        case K_MIX: if (EN(K_MIX)) {
            const int nctx = ctx_out ? 8 : 0;
            const int nunits = 1024 + 2 * nctx + 520;
            const float* qkg = PIN(13) + (size_t)l * 256;
            { LAS float* btab = (LAS float*)(lds + 73728); const float* relb = PIN(22) + (size_t)l * 4 * 15 * 31;
              for (int i = tid; i < 7620; i += 512) { const int hd = i / 1905, rem = i % 1905, dr = rem / 127, d = rem % 127 - 63; btab[i] = (d >= -15 && d <= 15) ? relb[(hd * 15 + dr) * 31 + d + 15] * LOG2E : 0.f; }
              if (tid < 112) { const int kk = tid - 48; btab[7620 + tid] = (kk >= 0 && kk < 16) ? 0.f : -1e30f; }
              { float bm = 0.f; for (int i = tid; i < 4 * 15 * 31; i += 512) bm = fmaxf(bm, fabsf(relb[i]));
#pragma unroll
                for (int o = 1; o < 64; o <<= 1) bm = fmaxf(bm, __shfl_xor(bm, o));
                if (lane == 0) btab[7620 + 112 + wave] = bm * LOG2E; } }
            for (int uidx = bid; uidx < nunits; uidx += G) {
                int tidm = tid; asm volatile("" : "+v"(tidm));
                const int tbx = ((uidx & 7) << 5) | ((uidx & 255) >> 3);
                if (uidx < 512) attn_unit<true>(lds, UM, XB, qkg + 128, qkg + 192, nullptr, PIN(22) + (size_t)l * 4 * 15 * 31, ropeC, ropeS, uidx >> 8, tbx, false, tidm);
                else if (uidx < 1024) attn_unit<false>(lds, UM, XB, qkg, qkg + 64, PIN(14) + l * 4, nullptr, ropeC, ropeS, (uidx - 512) >> 8, tbx, false, tidm);
                else if (uidx < 1024 + nctx) { const int v = uidx - 1024; attn_unit<false>(lds, UM, XB, qkg, qkg + 64, PIN(14) + l * 4, nullptr, ropeC, ropeS, v >> 2, v & 3, true, tidm); }
                else if (uidx < 1024 + 2 * nctx) { const int v = uidx - 1024 - nctx; attn_unit<true>(lds, UM, XB, qkg + 128, qkg + 192, nullptr, PIN(22) + (size_t)l * 4 * 15 * 31, ropeC, ropeS, v >> 2, v & 3, true, tidm); }
                else {
                    const int v = uidx - 1024 - 2 * nctx;
                    int rowbase, t0, T;
                    if (v < 512) { rowbase = (v >> 8) * SEQ; t0 = (v & 255) * 64; T = SEQ; } else { const int c = v - 512; rowbase = ML + (c >> 2) * CTXL; t0 = (c & 3) * 64; T = CTXL; }
                    const int c8 = (tidm & 31) * 8, tr = tidm >> 5;
                    float wA[3][8], wL[4][8], bL[8];
#pragma unroll
                    for (int k = 0; k < 3; ++k)
#pragma unroll
                        for (int j = 0; j < 8; ++j) wA[k][j] = PIN(12)[((size_t)l * 3 + k) * 256 + c8 + j];
#pragma unroll
                    for (int k = 0; k < 4; ++k)
#pragma unroll
                        for (int j = 0; j < 8; ++j) wL[k][j] = PIN(15)[((size_t)l * 4 + k) * 256 + c8 + j];
#pragma unroll
                    for (int j = 0; j < 8; ++j) bL[j] = PIN(16)[(size_t)l * 256 + c8 + j];
                    for (int ps = 0; ps < 4; ++ps) {
                        const int t = t0 + ps * 16 + tr;
                        const bf16_t* ur = UM + (size_t)(rowbase + t) * NMIX;
                        float accA[8], accL[8];
#pragma unroll
                        for (int j = 0; j < 8; ++j) { accA[j] = 0.f; accL[j] = bL[j]; }
#pragma unroll
                        for (int k = 0; k < 3; ++k) { const int tt = t + k - 1; if (tt >= 0 && tt < T) { const bf16_t* p = ur + (ptrdiff_t)(k - 1) * NMIX; float a[8], c[8]; unpack8(*(const u32x4*)(p + c8), a); unpack8(*(const u32x4*)(p + 512 + c8), c);
#pragma unroll
                                for (int j = 0; j < 8; ++j) accA[j] += wA[k][j] * (a[j] * c[j]); } }
#pragma unroll
                        for (int k = 0; k < 4; ++k) { const int tt = t + k - 2; if (tt >= 0 && tt < T) { float a[8]; unpack8(*(const u32x4*)(ur + (ptrdiff_t)(k - 2) * NMIX + 1280 + c8), a);
#pragma unroll
                                for (int j = 0; j < 8; ++j) accL[j] += wL[k][j] * a[j]; } }
                        float gb[8]; unpack8(*(const u32x4*)(ur + 256 + c8), gb);
                        u32x4 o; o.x = cvt_pk(gb[0] * accA[0], gb[1] * accA[1]); o.y = cvt_pk(gb[2] * accA[2], gb[3] * accA[3]); o.z = cvt_pk(gb[4] * accA[4], gb[5] * accA[5]); o.w = cvt_pk(gb[6] * accA[6], gb[7] * accA[7]);
                        bf16_t* yr = XB + (size_t)(rowbase + t) * D;
                        *(u32x4*)(yr + c8) = o;
                        u32x4 o2; o2.x = cvt_pk(accL[0], accL[1]); o2.y = cvt_pk(accL[2], accL[3]); o2.z = cvt_pk(accL[4], accL[5]); o2.w = cvt_pk(accL[6], accL[7]);
                        *(u32x4*)(yr + 512 + c8) = o2;
                    }
                }
            }
        } break;
        case K_LRU_SUM: if (EN(K_LRU_SUM)) {
            const int dir = tid >> 8, ch = tid & 255;
            for (int cid = bid; cid < 260; cid += 2 * G) {
                const int cid2 = cid + G;
                const bool two = cid2 < 260;
                const int row0 = cid < 256 ? cid * 128 : ML + (cid - 256) * 128;
                const int row1 = two ? (cid2 < 256 ? cid2 * 128 : ML + (cid2 - 256) * 128) : row0;
                const unsigned* a = (const unsigned*)AB + ((size_t)dir * MT + row0) * 256 + ch;
                const unsigned* a2 = (const unsigned*)AB + ((size_t)dir * MT + row1) * 256 + ch;
                float Ap = 1.f, H = 0.f, Ap2 = 1.f, H2 = 0.f;
                if (!two) {
                    if (dir == 0) {
#pragma unroll 16
                        for (int t = 0; t < 128; ++t) { const unsigned w = a[(size_t)t * 256]; const float av = 1.0f - bflo(w), bv = bfhi(w); H = av * H + bv; Ap *= av; }
                    } else {
#pragma unroll 16
                        for (int t = 127; t >= 0; --t) { const unsigned w = a[(size_t)t * 256]; const float av = 1.0f - bflo(w), bv = bfhi(w); H = av * H + bv; Ap *= av; }
                    }
                } else {
                    if (dir == 0) {
#pragma unroll 8
                        for (int t = 0; t < 128; ++t) { const unsigned w = a[(size_t)t * 256], w2 = a2[(size_t)t * 256]; const float av = 1.0f - bflo(w), bv = bfhi(w), av2 = 1.0f - bflo(w2), bv2 = bfhi(w2);
                            H = av * H + bv; Ap *= av; H2 = av2 * H2 + bv2; Ap2 *= av2; }
                    } else {
#pragma unroll 8
                        for (int t = 127; t >= 0; --t) { const unsigned w = a[(size_t)t * 256], w2 = a2[(size_t)t * 256]; const float av = 1.0f - bflo(w), bv = bfhi(w), av2 = 1.0f - bflo(w2), bv2 = bfhi(w2);
                            H = av * H + bv; Ap *= av; H2 = av2 * H2 + bv2; Ap2 *= av2; }
                    }
                    SUM[((size_t)dir * 260 + cid2) * 256 + ch] = (f32x2){Ap2, H2};
                }
                SUM[((size_t)dir * 260 + cid) * 256 + ch] = (f32x2){Ap, H};
            }
        } break;
        case K_LRU_FIN: if (EN(K_LRU_FIN)) {
            LAS bf16_t* hb16 = (LAS bf16_t*)lds;
            bf16_t* SCR = (bf16_t*)PART;
            const int dir = tid >> 8, ch = tid & 255;
            for (int cid = bid; cid < 256; cid += G) {
                __syncthreads();
                const bool two = ctx_out && cid < 4;
                const int b = cid >> 7, c = cid & 127;
                const int row0 = cid * 128, row1 = ML + cid * 128;
                const int nctxc = 2;
                const int nlat = dir == 0 ? c : 127 - c;
                const int ntot = nctxc + nlat;
                const f32x2* sp = SUM + (size_t)dir * 260 * 256 + ch;
                float H = 0.f;
                for (int k0 = 0; k0 < ntot; k0 += 8) {
                    f32x2 sv[8];
#pragma unroll
                    for (int j = 0; j < 8; ++j) {
                        const int k = k0 + j; const bool ok = k < ntot; const int kk = ok ? k : 0;
                        const int id = kk < nctxc ? 256 + 2 * b + (dir == 0 ? kk : 1 - kk) : 128 * b + (dir == 0 ? (kk - nctxc) : 127 - (kk - nctxc));
                        const f32x2 v = sp[(size_t)id * 256];
                        sv[j] = ok ? v : (f32x2){1.f, 0.f};
                    }
#pragma unroll
                    for (int j = 0; j < 8; ++j) H = sv[j].x * H + sv[j].y;
                }
                const unsigned* ap = (const unsigned*)AB + ((size_t)dir * MT + row0) * 256 + ch;
                LAS bf16_t* hp = hb16 + dir * (128 * 256) + ch;
                float h = H;
                if (!two) {
                    if (dir == 0) {
#pragma unroll 16
                        for (int t = 0; t < 128; ++t) { const unsigned w = ap[(size_t)t * 256]; h = (1.0f - bflo(w)) * h + bfhi(w); hp[t * 256] = (bf16_t)f2bf(h); }
                    } else {
#pragma unroll 16
                        for (int t = 127; t >= 0; --t) { const unsigned w = ap[(size_t)t * 256]; h = (1.0f - bflo(w)) * h + bfhi(w); hp[t * 256] = (bf16_t)f2bf(h); }
                    }
                } else {
                    const int c2 = cid & 1, b2 = cid >> 1;
                    const bool has = dir == 0 ? (c2 == 1) : (c2 == 0);
                    float h2 = has ? sp[(size_t)(256 + 2 * b2 + (dir == 0 ? 0 : 1)) * 256].y : 0.f;
                    const unsigned* ap2 = (const unsigned*)AB + ((size_t)dir * MT + row1) * 256 + ch;
                    bf16_t* gp = SCR + ((size_t)(cid * 2 + dir) * 128) * 256 + ch;
                    if (dir == 0) {
#pragma unroll 8
                        for (int t = 0; t < 128; ++t) { const unsigned w = ap[(size_t)t * 256], w2 = ap2[(size_t)t * 256];
                            h = (1.0f - bflo(w)) * h + bfhi(w); hp[t * 256] = (bf16_t)f2bf(h); h2 = (1.0f - bflo(w2)) * h2 + bfhi(w2); gp[(size_t)t * 256] = (bf16_t)f2bf(h2); }
                    } else {
#pragma unroll 8
                        for (int t = 127; t >= 0; --t) { const unsigned w = ap[(size_t)t * 256], w2 = ap2[(size_t)t * 256];
                            h = (1.0f - bflo(w)) * h + bfhi(w); hp[t * 256] = (bf16_t)f2bf(h); h2 = (1.0f - bflo(w2)) * h2 + bfhi(w2); gp[(size_t)t * 256] = (bf16_t)f2bf(h2); }
                    }
                }
                __syncthreads();
#pragma unroll 2
                for (int g = 0; g < 8; ++g) {
                    const int idx = g * 512 + tid, t = idx >> 5, c8 = (idx & 31) * 8;
                    float f[8], r[8], gg[8];
                    unpack8(*(const LAS u32x4*)(hb16 + t * 256 + c8), f); unpack8(*(const LAS u32x4*)(hb16 + 128 * 256 + t * 256 + c8), r);
                    unpack8(*(const u32x4*)(UM + (size_t)(row0 + t) * NMIX + 1536 + c8), gg);
                    u32x4 o; o.x = cvt_pk((f[0] + r[0]) * gelu_tanh(gg[0]), (f[1] + r[1]) * gelu_tanh(gg[1])); o.y = cvt_pk((f[2] + r[2]) * gelu_tanh(gg[2]), (f[3] + r[3]) * gelu_tanh(gg[3]));
                    o.z = cvt_pk((f[4] + r[4]) * gelu_tanh(gg[4]), (f[5] + r[5]) * gelu_tanh(gg[5])); o.w = cvt_pk((f[6] + r[6]) * gelu_tanh(gg[6]), (f[7] + r[7]) * gelu_tanh(gg[7]));
                    *(u32x4*)(XB + (size_t)(row0 + t) * D + 512 + c8) = o;
                }
                if (two) {
                    const bf16_t* s0 = SCR + ((size_t)(cid * 2 + 0) * 128) * 256; const bf16_t* s1 = SCR + ((size_t)(cid * 2 + 1) * 128) * 256;
#pragma unroll 2
                    for (int g = 0; g < 8; ++g) {
                        const int idx = g * 512 + tid, t = idx >> 5, c8 = (idx & 31) * 8;
                        float f[8], r[8], gg[8];
                        unpack8(*(const u32x4*)(s0 + t * 256 + c8), f); unpack8(*(const u32x4*)(s1 + t * 256 + c8), r);
                        unpack8(*(const u32x4*)(UM + (size_t)(row1 + t) * NMIX + 1536 + c8), gg);
                        u32x4 o; o.x = cvt_pk((f[0] + r[0]) * gelu_tanh(gg[0]), (f[1] + r[1]) * gelu_tanh(gg[1])); o.y = cvt_pk((f[2] + r[2]) * gelu_tanh(gg[2]), (f[3] + r[3]) * gelu_tanh(gg[3]));
                        o.z = cvt_pk((f[4] + r[4]) * gelu_tanh(gg[4]), (f[5] + r[5]) * gelu_tanh(gg[5])); o.w = cvt_pk((f[6] + r[6]) * gelu_tanh(gg[6]), (f[7] + r[7]) * gelu_tanh(gg[7]));
                        *(u32x4*)(XB + (size_t)(row1 + t) * D + 512 + c8) = o;
                    }
                }
            }
        } break;
        default: break;
        }
        if (step + 1 < P.hi || rep == 0) {
            if (P.hi < 0) grid.sync();
            xcd_barrier((unsigned*)ws, (volatile LAS unsigned*)(lds + LDS_BAR_OFF), tid);
        }
        for (int xs = 0; xs < XSYNC; ++xs) xcd_barrier((unsigned*)ws, (volatile LAS unsigned*)(lds + LDS_BAR_OFF), tid);
    }
}

extern "C" void kernel_launch(void* const* d_in, const int* in_sizes, int n_in, void* d_out, int out_size, void* d_ws, size_t ws_size, hipStream_t stream) {
    static int grid = 0;
    if (grid == 0) {
        if (n_in != 25 || out_size != ML * D || ws_size < WS_NEED) { fprintf(stderr, "kernel_launch: unexpected shapes (n_in %d out %d ws %zu need %zu)\n", n_in, out_size, ws_size, (size_t)WS_NEED); grid = -1; return; }
        int dev = 0, cus = 0, per_cu = 0;
        (void)hipGetDevice(&dev);
        (void)hipDeviceGetAttribute(&cus, hipDeviceAttributeMultiprocessorCount, dev);
        (void)hipFuncSetAttribute((const void*)fwd_mega_t<KMASK>, hipFuncAttributeMaxDynamicSharedMemorySize, LDS_BYTES);
        (void)hipOccupancyMaxActiveBlocksPerMultiprocessor(&per_cu, (const void*)fwd_mega_t<KMASK>, 512, LDS_BYTES);
        if (per_cu < 1) per_cu = 1;
        (void)hipGetLastError();
        grid = cus * 1;
        fprintf(stderr, "kernel_launch: cus %d per_cu %d grid %d ws %zu\n", cus, per_cu, grid, ws_size);
    }
    if (grid < 0) return;
    Params p{};
    for (int i = 0; i < 25; ++i) p.in[i] = (const float*)d_in[i];
    p.out = (float*)d_out; p.ws = (unsigned char*)d_ws;
    (void)hipMemsetAsync(d_ws, 0, 65536, stream);
    p.lo = 0; p.hi = N_STEPS;
    void* args[] = {&p};
    hipError_t e = hipLaunchCooperativeKernel((const void*)fwd_mega_t<KMASK>, dim3(grid), dim3(512), args, LDS_BYTES, stream);
    if (e != hipSuccess) fprintf(stderr, "cooperative launch failed: %s (grid %d)\n", hipGetErrorString(e), grid);
}
```

```cpp
#include <hip/hip_runtime.h>
#include <hip/hip_cooperative_groups.h>
#include <cstdio>
#include <cstdint>
namespace cg = cooperative_groups;


#ifndef KMASK
#define KMASK 0xFFFF
#endif
#define EN(k) (((KM) >> (k)) & 1)
#ifndef DBL_MASK
#define DBL_MASK 0
#endif
#ifndef XSYNC
#define XSYNC 0
#endif
#define LAS __attribute__((address_space(3)))
typedef unsigned short bf16_t;
typedef short bf16x8 __attribute__((ext_vector_type(8)));
typedef float f32x4 __attribute__((ext_vector_type(4)));
typedef float f32x2 __attribute__((ext_vector_type(2)));
typedef float f32x16 __attribute__((ext_vector_type(16)));
typedef unsigned u32x4 __attribute__((ext_vector_type(4)));
typedef unsigned u32x2 __attribute__((ext_vector_type(2)));

constexpr int D = 1024, SEQ = 16384, CTXL = 256, DFF = 2816, INW = 6656, NMIX = 2560;
constexpr int ML = 2 * SEQ, MC = 2 * CTXL, MT = ML + MC;
constexpr int NMOD = 9 * D;
constexpr float EPS = 1e-6f;
constexpr float LOG2E = 1.4426950408889634f;

constexpr size_t MiB = 1u << 20;
constexpr size_t OFF_MOD = 1 * MiB;
constexpr size_t OFF_GS = OFF_MOD + 256 * 1024;
constexpr size_t OFF_BIAS = OFF_GS + 128 * 1024;
constexpr size_t OFF_ROPE = OFF_BIAS + 256 * 1024;
constexpr size_t OFF_LRUC = OFF_ROPE + 64 * 1024;
constexpr size_t OFF_SUM = 2 * MiB;
constexpr size_t OFF_SSQ = 4 * MiB;
constexpr size_t OFF_XC = 7 * MiB;
constexpr size_t OFF_W = 9 * MiB;
constexpr size_t W_W1A = OFF_W;
constexpr size_t W_WDA = W_W1A + (size_t)5632 * 1024 * 2;
constexpr size_t W_WIN = W_WDA + (size_t)1024 * 2816 * 2;
constexpr size_t W_WBR = W_WIN + (size_t)6656 * 1024 * 2;
constexpr size_t W_WOUT = W_WBR + (size_t)(4096 + 128) * 256 * 2;
constexpr size_t W_W1B = W_WOUT + (size_t)1024 * 1024 * 2;
constexpr size_t W_WDB = W_W1B + (size_t)5632 * 1024 * 2;
constexpr size_t W_WLRU = W_WDB + (size_t)1024 * 2816 * 2;
constexpr size_t W_END = W_WLRU + (size_t)1024 * 256 * 2;
constexpr size_t OFF_XA = 61 * MiB;
constexpr size_t OFF_XB = 126 * MiB;
constexpr size_t OFF_R = 191 * MiB;
constexpr size_t OFF_GL = OFF_R + (size_t)MT * NMIX * 2;
constexpr size_t OFF_PART = 486 * MiB;
constexpr size_t WS_NEED = OFF_PART + (size_t)11 * MC * D * 4;
static_assert(OFF_GL + (size_t)66 * 256 * 4096 * 2 <= OFF_PART, "gl/part");
static_assert(W_END <= OFF_XA, "weights");
static_assert(OFF_XA + (size_t)MT * D * 2 <= OFF_XB && OFF_XB + (size_t)MT * D * 2 <= OFF_R, "xa/xb");
static_assert((size_t)4 * MT * 256 * 4 <= (size_t)66 * 256 * 4096 * 2, "ab fits gl");
static_assert(WS_NEED <= 512 * MiB, "ws");

constexpr int LDS_BYTES = 147456;

struct Params { const float* in[25]; float* out; unsigned char* ws; int lo, hi; };

__device__ __forceinline__ float bflo(unsigned w) { return __uint_as_float(w << 16); }
__device__ __forceinline__ float bfhi(unsigned w) { return __uint_as_float(w & 0xffff0000u); }
__device__ __forceinline__ float bf1(bf16_t u) { return __uint_as_float((unsigned)u << 16); }
typedef __bf16 bf16x2_t __attribute__((ext_vector_type(2)));
__device__ __forceinline__ unsigned cvt_pk(float lo, float hi) { const f32x2 v = {lo, hi}; const bf16x2_t b = __builtin_convertvector(v, bf16x2_t); return __builtin_bit_cast(unsigned, b); }
__device__ __forceinline__ float fast_sigmoid(float v) { return __builtin_amdgcn_rcpf(1.0f + __expf(-v)); }
__device__ __forceinline__ float wave_sum(float v) {
#pragma unroll
    for (int o = 1; o < 64; o <<= 1) v += __shfl_xor(v, o);
    return v;
}
__device__ __forceinline__ int mi_of_tile(int pm) { return pm < 64 ? 0 : (pm < 128 ? 1 : 2); }
__device__ __forceinline__ float row_rstd(const float* ssq, int row) {
    const f32x4* p = (const f32x4*)(ssq + (size_t)row * 16);
    const f32x4 a = p[0], b = p[1], c = p[2], d = p[3];
    const float s = ((a.x + a.y) + (a.z + a.w)) + ((b.x + b.y) + (b.z + b.w)) + ((c.x + c.y) + (c.z + c.w)) + ((d.x + d.y) + (d.z + d.w));
    return rsqrtf(s * (1.0f / 1024.0f) + EPS);
}

namespace pg8 {
constexpr int BM = 256, BK = 64, HALF = 128, HTB = HALF * BK * 2, NXCD = 8, WGM = 8;
__host__ __device__ __forceinline__ int lds_byte(int r, int c) { const int st = (r >> 4) * 2 + (c >> 5), rr = r & 15, cc = c & 31, ob = rr * 64 + cc * 2; return st * 1024 + (ob ^ (((ob >> 9) & 1) << 5)); }
__host__ __device__ __forceinline__ void stage_rc(int b, int& R, int& C) { const int st = b / 1024, sb = b % 1024, swz = sb ^ (((sb >> 9) & 1) << 5); R = (st >> 1) * 16 + swz / 64; C = (st & 1) * 32 + (swz % 64) / 2; }
__host__ __device__ __forceinline__ int perm32(int rho) { const int n = rho >> 4, i = rho & 15; return 8 * (i >> 2) + 4 * n + (i & 3); }

struct Unit { int pm, pn, aux, nt; const char* A; const char* B; };

struct SchedStd {
    int m0, nM, nN, nwg, G, c, nt, kofs = 0; const char* A; const char* B; size_t tA, tB;
    __device__ __forceinline__ void init(int m0_, int nM_, int nN_, int G_, int c_, const void* A_, int lda, const void* B_, int ldb, int K_) {
        m0 = m0_; nM = nM_; nN = nN_; nwg = nM * nN; G = G_; c = c_; nt = K_ / BK; A = (const char*)A_; B = (const char*)B_; tA = (size_t)BM * lda * 2; tB = (size_t)BM * ldb * 2; }
    __device__ __forceinline__ bool next(int i, Unit& u) const {
        const long L = (long)i * G + c; if (L >= nwg) return false;
        int wgid = (int)L; { const int q = nwg / NXCD, r = nwg % NXCD, xcd = wgid % NXCD, off = wgid / NXCD; wgid = (xcd < r ? xcd * (q + 1) : r * (q + 1) + (xcd - r) * q) + off; }
        const int nig = WGM * nN, gid = wgid / nig, fm = gid * WGM, gsz = (nM - fm) < WGM ? (nM - fm) : WGM;
        const int pm = fm + ((wgid % nig) % gsz), pn = (wgid % nig) / gsz;
        u.pm = m0 + pm; u.pn = pn; u.aux = 0; u.nt = nt; u.A = A + (size_t)u.pm * tA + (pn & 1) * kofs; u.B = B + (size_t)pn * tB + (pn & 1) * kofs; return true;
    }
};
struct SchedDn {
    SchedStd std; int nctx;
    __device__ __forceinline__ bool next(int i, Unit& u) const {
        const int li = (std.c < nctx) ? i - 1 : i;
        if (li < 0) { const int pmc = std.c / 44, rest = std.c % 44, pn = rest / 11, ks = rest % 11;
            u.pm = 128 + pmc; u.pn = pn; u.aux = ks + 1; u.nt = 4; u.A = std.A + (size_t)u.pm * std.tA + ks * 512; u.B = std.B + (size_t)pn * std.tB + ks * 512; return true; }
        return std.next(li, u);
    }
};
struct SchedBr {
    int m0, nM, G, c; const char* A; const char* B;
    __device__ __forceinline__ bool next(int i, Unit& u) const {
        const int sup = i >> 2, b = i & 3; const long L = (long)sup * G + c; if (L >= (long)nM * 8) return false;
        u.pm = m0 + (int)(L >> 3); u.pn = (int)(L & 7); u.aux = b; u.nt = 4;
        u.A = A + (size_t)u.pm * (BM * 1024 * 2) + b * 512; u.B = B + (size_t)b * (1024 * 256 * 2) + (size_t)u.pn * (128 * 256 * 2); return true;
    }
};

template <class Epi, class Sched, int NBJ>
__device__ __forceinline__ void gemm_phase(LAS unsigned char* lds, const int tid, const int K, const int lda, const int ldb, const Sched& S, const Epi& E) {
    const int wid = __builtin_amdgcn_readfirstlane(tid >> 6), lane = tid & 63, wr = wid >> 2, wc = wid & 3, fr = lane & 15, fq = lane >> 4;
    unsigned voffA[2], voffB[2];
#pragma unroll
    for (int i = 0; i < 2; ++i) { int R, C; stage_rc(tid * 16 + i * 8192, R, C); const int Rb = (R & ~31) + perm32(R & 31);
        voffA[i] = (unsigned)(R * lda + C) * 2u; voffB[i] = (unsigned)(Rb * ldb + C) * 2u; }
    const size_t kstep = (size_t)(BK * 2);
    const size_t hA = (size_t)HALF * lda * 2, hB = (size_t)HALF * ldb * 2;
    const unsigned ldsw = (unsigned)wid * 1024u;
    const int aoff = lds_byte(wr * 64 + fr, fq * 8), boff = lds_byte(wc * 32 + fr, fq * 8);
#define PG8_SA(b, h) (((b) * 2 + (h)) * HTB)
#define PG8_SB(b, h) ((4 + (b) * 2 + (h)) * HTB)
#define PG8_STAGE(bufoff, gbase, voff) do { _Pragma("unroll") for (int _i = 0; _i < 2; ++_i) \
        __builtin_amdgcn_global_load_lds((const unsigned*)((const char*)(gbase) + (voff)[_i]), (LAS unsigned*)(lds + (bufoff) + ldsw + _i * 8192), 16, 0, 0); } while (0)
#define PG8_LDA(dst, b, h) do { _Pragma("unroll") for (int m = 0; m < 4; ++m) _Pragma("unroll") for (int k = 0; k < 2; ++k) dst[m][k] = *(const LAS bf16x8*)(lds + PG8_SA(b, h) + aoff + m * 2048 + k * 1024); } while (0)
#define PG8_LDB(dst, b, h) do { _Pragma("unroll") for (int n = 0; n < 2; ++n) _Pragma("unroll") for (int k = 0; k < 2; ++k) dst[n][k] = *(const LAS bf16x8*)(lds + PG8_SB(b, h) + boff + n * 2048 + k * 1024); } while (0)
#define PG8_MMA(ai, bj, At, Bt) do { if ((bj) < NBJ) { __builtin_amdgcn_s_setprio(1); _Pragma("unroll") for (int m = 0; m < 4; ++m) _Pragma("unroll") for (int n = 0; n < 2; ++n) _Pragma("unroll") for (int k = 0; k < 2; ++k) \
        acc[ai][bj][m][n] = __builtin_amdgcn_mfma_f32_16x16x32_bf16(Bt[n][k], At[m][k], acc[ai][bj][m][n], 0, 0, 0); __builtin_amdgcn_s_setprio(0); } } while (0)
#define PG8_WAIT_V(n) asm volatile("s_waitcnt vmcnt(" #n ")" ::: "memory")
#define PG8_WAIT_L(n) asm volatile("s_waitcnt lgkmcnt(" #n ")" ::: "memory")
#define PG8_BAR __builtin_amdgcn_s_barrier()
#define PG8_SCHED __builtin_amdgcn_sched_barrier(0)
    Unit cur, nxt; int ui = 0;
    if (!S.next(0, cur)) return;
    f32x4 acc[2][2][4][2];
#pragma unroll
    for (int a = 0; a < 2; ++a)
#pragma unroll
        for (int b = 0; b < 2; ++b)
#pragma unroll
            for (int m = 0; m < 4; ++m)
#pragma unroll
                for (int n = 0; n < 2; ++n) acc[a][b][m][n] = (f32x4){0.f, 0.f, 0.f, 0.f};
    bf16x8 At[4][2], B0[2][2], B1[2][2];
    const char* cA = cur.A; const char* cB = cur.B;
    PG8_STAGE(PG8_SB(0, 0), cB, voffB); PG8_STAGE(PG8_SB(0, 1), cB + hB, voffB); PG8_STAGE(PG8_SA(0, 0), cA, voffA); PG8_STAGE(PG8_SA(0, 1), cA + hA, voffA);
    if (wr == 1) PG8_BAR;
    PG8_WAIT_V(2); PG8_BAR;
    PG8_STAGE(PG8_SB(1, 0), cB + kstep, voffB); PG8_STAGE(PG8_SA(1, 0), cA + kstep, voffA); PG8_STAGE(PG8_SB(1, 1), cB + hB + kstep, voffB);
    PG8_WAIT_V(6); PG8_BAR;
    for (;;) {
        const bool has_next = S.next(ui + 1, nxt);
        const char* nA = has_next ? nxt.A : cA; const char* nB = has_next ? nxt.B : cB;
        const int nt = cur.nt;
        for (int t = 0; t < nt; t += 2) {
            const bool last = (t == nt - 2);
            const char* a1 = cA + (size_t)(t + 1) * kstep;
            const char* a2 = last ? nA : cA + (size_t)(t + 2) * kstep; const char* b2 = last ? nB : cB + (size_t)(t + 2) * kstep;
            const char* a3 = a2 + kstep; const char* b3 = b2 + kstep;
            PG8_LDB(B0, 0, 0); PG8_LDB(B1, 0, 1); PG8_SCHED; PG8_LDA(At, 0, 0); PG8_STAGE(PG8_SA(1, 1), a1 + hA, voffA);
            PG8_WAIT_V(8); PG8_WAIT_L(0); PG8_BAR; PG8_MMA(0, 0, At, B0); PG8_MMA(0, 1, At, B1); PG8_BAR; PG8_SCHED;
            PG8_LDA(At, 0, 1); PG8_STAGE(PG8_SB(0, 0), b2, voffB); PG8_STAGE(PG8_SB(0, 1), b2 + hB, voffB); PG8_STAGE(PG8_SA(0, 0), a2, voffA);
            PG8_WAIT_V(8); PG8_WAIT_L(0); PG8_BAR; PG8_MMA(1, 0, At, B0); PG8_MMA(1, 1, At, B1); PG8_BAR; PG8_SCHED;
            PG8_LDB(B0, 1, 0); PG8_LDB(B1, 1, 1); PG8_SCHED; PG8_LDA(At, 1, 0); PG8_STAGE(PG8_SA(0, 1), a2 + hA, voffA);
            PG8_WAIT_V(8); PG8_WAIT_L(0); PG8_BAR; PG8_MMA(0, 0, At, B0); PG8_MMA(0, 1, At, B1); PG8_BAR; PG8_SCHED;
            PG8_LDA(At, 1, 1); PG8_STAGE(PG8_SB(1, 0), b3, voffB); PG8_STAGE(PG8_SB(1, 1), b3 + hB, voffB); PG8_STAGE(PG8_SA(1, 0), a3, voffA);
            PG8_WAIT_V(8); PG8_WAIT_L(0); PG8_BAR; PG8_MMA(1, 0, At, B0); PG8_MMA(1, 1, At, B1); PG8_BAR; PG8_SCHED;
        }
        if (wr == 0) PG8_BAR;
        { int fr_o = fr, fq_o = fq; asm volatile("" : "+v"(fr_o), "+v"(fq_o));
          E(acc, cur, wr, wc, fr_o, fq_o); }
        if (!has_next) break;
#pragma unroll
        for (int a = 0; a < 2; ++a)
#pragma unroll
            for (int b = 0; b < NBJ; ++b)
#pragma unroll
                for (int m = 0; m < 4; ++m)
#pragma unroll
                    for (int n = 0; n < 2; ++n) acc[a][b][m][n] = (f32x4){0.f, 0.f, 0.f, 0.f};
        cur = nxt; cA = nA; cB = nB; ++ui;
        if (wr == 1) PG8_BAR;
    }
    PG8_WAIT_V(0);
    PG8_BAR;
#undef PG8_SA
#undef PG8_SB
#undef PG8_STAGE
#undef PG8_LDA
#undef PG8_LDB
#undef PG8_MMA
#undef PG8_WAIT_V
#undef PG8_WAIT_L
#undef PG8_BAR
#undef PG8_SCHED
}

struct EpiSwiGLU {
    const float* ssq; const float* bias; bf16_t* act;
    __device__ __forceinline__ void operator()(f32x4 (&acc)[2][2][4][2], const Unit& u, int wr, int wc, int fr, int fq) const {
        const int mi = mi_of_tile(u.pm);
        const float* bs = bias + mi * 5632 + u.pn * 256 + wc * 32 + 8 * fq;
        const f32x4 bg0 = *(const f32x4*)(bs), bg1 = *(const f32x4*)(bs + 4), bu0 = *(const f32x4*)(bs + 128), bu1 = *(const f32x4*)(bs + 132);
        const int col = u.pn * 128 + wc * 32 + 8 * fq;
#pragma unroll
        for (int ai = 0; ai < 2; ++ai)
#pragma unroll
            for (int m = 0; m < 4; ++m) {
                const int row = u.pm * 256 + ai * 128 + wr * 64 + m * 16 + fr;
                const float rs = row_rstd(ssq, row);
                const f32x4 g0 = acc[ai][0][m][0] * rs + bg0, g1 = acc[ai][0][m][1] * rs + bg1, u0 = acc[ai][1][m][0] * rs + bu0, u1 = acc[ai][1][m][1] * rs + bu1;
                float o[8];
#pragma unroll
                for (int j = 0; j < 4; ++j) { o[j] = g0[j] * fast_sigmoid(g0[j]) * u0[j]; o[4 + j] = g1[j] * fast_sigmoid(g1[j]) * u1[j]; }
                u32x4 w; w.x = cvt_pk(o[0], o[1]); w.y = cvt_pk(o[2], o[3]); w.z = cvt_pk(o[4], o[5]); w.w = cvt_pk(o[6], o[7]);
                *(u32x4*)(act + (size_t)row * DFF + col) = w;
            }
    }
};
struct EpiRes {
    const float* xinL; const float* xinC; float* xoutL; float* xoutC; const float* gate; const float* gsn; bf16_t* xs; float* ssq; float* part; int wxs;
    __device__ __forceinline__ void operator()(f32x4 (&acc)[2][2][4][2], const Unit& u, int wr, int wc, int fr, int fq) const {
        const int mi = mi_of_tile(u.pm);
        const int col = u.pn * 256 + wc * 32 + 8 * fq;
        if (u.aux > 0) {
            float* pp = part + ((size_t)(u.aux - 1) * MC) * D + col;
#pragma unroll
            for (int ai = 0; ai < 2; ++ai)
#pragma unroll
                for (int m = 0; m < 4; ++m) {
                    const int row = u.pm * 256 + ai * 128 + wr * 64 + m * 16 + fr - ML;
#pragma unroll
                    for (int bj = 0; bj < 2; ++bj) { *(f32x4*)(pp + (size_t)row * D + bj * 128) = acc[ai][bj][m][0]; *(f32x4*)(pp + (size_t)row * D + bj * 128 + 4) = acc[ai][bj][m][1]; }
                }
            return;
        }
        f32x4 gv[2][2], gs[2][2];
#pragma unroll
        for (int bj = 0; bj < 2; ++bj)
#pragma unroll
            for (int n = 0; n < 2; ++n) {
                gv[bj][n] = *(const f32x4*)(gate + mi * NMOD + col + bj * 128 + 4 * n);
                gs[bj][n] = *(const f32x4*)(gsn + mi * 1024 + col + bj * 128 + 4 * n);
            }
        const bool lat = u.pm < 128;
        const float* xi = lat ? xinL : xinC - (size_t)ML * D; float* xo = lat ? xoutL : xoutC - (size_t)ML * D;
#pragma unroll
        for (int ai = 0; ai < 2; ++ai)
#pragma unroll
            for (int m = 0; m < 4; ++m) {
                const int row = u.pm * 256 + ai * 128 + wr * 64 + m * 16 + fr;
                const size_t off = (size_t)row * D + col;
                float ss = 0.f;
#pragma unroll
                for (int bj = 0; bj < 2; ++bj) {
                    const f32x4 x0 = __builtin_nontemporal_load((const f32x4*)(xi + off + bj * 128)) + gv[bj][0] * acc[ai][bj][m][0];
                    const f32x4 x1 = __builtin_nontemporal_load((const f32x4*)(xi + off + bj * 128 + 4)) + gv[bj][1] * acc[ai][bj][m][1];
                    __builtin_nontemporal_store(x0, (f32x4*)(xo + off + bj * 128)); __builtin_nontemporal_store(x1, (f32x4*)(xo + off + bj * 128 + 4));
                    if (wxs) {
                        ss += (x0[0] * x0[0] + x0[1] * x0[1]) + (x0[2] * x0[2] + x0[3] * x0[3]) + (x1[0] * x1[0] + x1[1] * x1[1]) + (x1[2] * x1[2] + x1[3] * x1[3]);
                        const f32x4 y0 = x0 * gs[bj][0], y1 = x1 * gs[bj][1];
                        u32x4 w; w.x = cvt_pk(y0[0], y0[1]); w.y = cvt_pk(y0[2], y0[3]); w.z = cvt_pk(y1[0], y1[1]); w.w = cvt_pk(y1[2], y1[3]);
                        *(u32x4*)(xs + off + bj * 128) = w;
                    }
                }
                if (wxs) { ss += __shfl_xor(ss, 16); ss += __shfl_xor(ss, 32); if (fq == 0) ssq[(size_t)row * 16 + u.pn * 4 + wc] = ss; }
            }
    }
};
template <int ACT> struct EpiLin {
    const float* ssq; const float* bias; int bstride; bf16_t* out; int ldc; int rowbase;
    __device__ __forceinline__ void operator()(f32x4 (&acc)[2][2][4][2], const Unit& u, int wr, int wc, int fr, int fq) const {
        const int mi = mi_of_tile(u.pm);
        const int col = u.pn * 256 + wc * 32 + 8 * fq;
        f32x4 bv[2][2];
#pragma unroll
        for (int bj = 0; bj < 2; ++bj)
#pragma unroll
            for (int n = 0; n < 2; ++n) bv[bj][n] = *(const f32x4*)(bias + (size_t)mi * bstride + col + bj * 128 + 4 * n);
#pragma unroll
        for (int ai = 0; ai < 2; ++ai)
#pragma unroll
            for (int m = 0; m < 4; ++m) {
                const int row = u.pm * 256 + ai * 128 + wr * 64 + m * 16 + fr;
                const float rs = row_rstd(ssq, row);
                bf16_t* op = out + (size_t)(row - rowbase) * ldc + col;
#pragma unroll
                for (int bj = 0; bj < 2; ++bj) {
                    f32x4 v0 = acc[ai][bj][m][0] * rs + bv[bj][0], v1 = acc[ai][bj][m][1] * rs + bv[bj][1];
                    if (ACT == 1) {
#pragma unroll
                        for (int j = 0; j < 4; ++j) { v0[j] = fast_sigmoid(v0[j]); v1[j] = fast_sigmoid(v1[j]); }
                    }
                    u32x4 w; w.x = cvt_pk(v0[0], v0[1]); w.y = cvt_pk(v0[2], v0[3]); w.z = cvt_pk(v1[0], v1[1]); w.w = cvt_pk(v1[2], v1[3]);
                    *(u32x4*)(op + bj * 128) = w;
                }
            }
    }
};
struct EpiLru {
    const bf16_t* ybuf; const float* lc; unsigned* ab;
    __device__ __forceinline__ void operator()(f32x4 (&acc)[2][2][4][2], const Unit& u, int wr, int wc, int fr, int fq) const {
        const int dir = u.pn >> 1, ch0 = (u.pn & 1) * 128 + wc * 32 + 8 * fq;
        unsigned* A = ab + ((size_t)dir * MT) * 256;
        const float* lcp = lc + dir * 256 + ch0;
#pragma unroll
        for (int n = 0; n < 2; ++n) {
            const f32x4 ba = *(const f32x4*)(lcp + 4 * n), bx = *(const f32x4*)(lcp + 512 + 4 * n), sp = *(const f32x4*)(lcp + 1024 + 4 * n);
#pragma unroll
            for (int ai = 0; ai < 2; ++ai)
#pragma unroll
                for (int m = 0; m < 4; ++m) {
                    asm volatile("" : "+v"(acc[ai][0][m][n]), "+v"(acc[ai][1][m][n]) :: "memory");
                    const int row = u.pm * 256 + ai * 128 + wr * 64 + m * 16 + fr;
                    const u32x2 uw = *(const u32x2*)(ybuf + (size_t)row * D + 512 + ch0 + 4 * n);
                    const float uf[4] = {bflo(uw.x), bfhi(uw.x), bflo(uw.y), bfhi(uw.y)};
                    u32x4 o;
#pragma unroll
                    for (int j = 0; j < 4; ++j) {
                        const float r = fast_sigmoid(acc[ai][0][m][n][j] + ba[j]), ig = fast_sigmoid(acc[ai][1][m][n][j] + bx[j]);
                        const float la = sp[j] * r, x = 2.0f * la;
                        float em2 = -x * (1.0f + x * (0.5f + x * (0.16666667f + x * (0.041666668f + x * 0.0083333338f))));
                        float em1 = -la * (1.0f + la * (0.5f + la * (0.16666667f + la * (0.041666668f + la * 0.0083333338f))));
                        if (x < -0.25f) { em2 = 1.0f - __expf(x); em1 = 1.0f - __expf(la); }
                        o[j] = cvt_pk(em1, __builtin_amdgcn_sqrtf(em2) * ig * uf[j]);
                    }
                    *(u32x4*)(A + (size_t)row * 256 + ch0 + 4 * n) = o;
                }
        }
    }
};
struct EpiBranch {
    const bf16_t* gl; int rowbase; bf16_t* out;
    __device__ __forceinline__ void operator()(f32x4 (&acc)[2][2][4][2], const Unit& u, int wr, int wc, int fr, int fq) const {
        const int col = u.pn * 128 + wc * 32 + 8 * fq, b = u.aux;
#pragma unroll
        for (int ai = 0; ai < 2; ++ai)
#pragma unroll
            for (int m = 0; m < 4; ++m) {
                const int row = u.pm * 256 + ai * 128 + wr * 64 + m * 16 + fr;
                const u32x4 gw = *(const u32x4*)(gl + (size_t)(row - rowbase) * 4096 + b * 1024 + col);
                f32x4 g0 = {bflo(gw.x), bfhi(gw.x), bflo(gw.y), bfhi(gw.y)}, g1 = {bflo(gw.z), bfhi(gw.z), bflo(gw.w), bfhi(gw.w)};
                acc[ai][1][m][0] += g0 * acc[ai][0][m][0]; acc[ai][1][m][1] += g1 * acc[ai][0][m][1];
                if (b == 3) {
                    const f32x4 v0 = acc[ai][1][m][0], v1 = acc[ai][1][m][1];
                    u32x4 w; w.x = cvt_pk(v0[0], v0[1]); w.y = cvt_pk(v0[2], v0[3]); w.z = cvt_pk(v1[0], v1[1]); w.w = cvt_pk(v1[2], v1[3]);
                    *(u32x4*)(out + (size_t)row * D + col) = w;
                    acc[ai][1][m][0] = (f32x4){0.f, 0.f, 0.f, 0.f}; acc[ai][1][m][1] = (f32x4){0.f, 0.f, 0.f, 0.f};
                }
            }
    }
};
}

__device__ __forceinline__ void unpack8(const u32x4 w, float* f) { f[0] = bflo(w.x); f[1] = bfhi(w.x); f[2] = bflo(w.y); f[3] = bfhi(w.y); f[4] = bflo(w.z); f[5] = bfhi(w.z); f[6] = bflo(w.w); f[7] = bfhi(w.w); }
__device__ __forceinline__ bf16x8 pack8(const float* f) { u32x4 w; w.x = cvt_pk(f[0], f[1]); w.y = cvt_pk(f[2], f[3]); w.z = cvt_pk(f[4], f[5]); w.w = cvt_pk(f[6], f[7]); return __builtin_bit_cast(bf16x8, w); }

template <bool NA>
__device__ __forceinline__ void attn_load_raw(u32x4 (&rk)[NA ? 4 : 2], u32x4 (&rv)[NA ? 4 : 2], const bf16_t* um, size_t krow0, int tid) {
    if (NA) {
        const int krow = tid >> 1, key = krow >> 2, hd = krow & 3, part = tid & 1;
        const bf16_t* p = um + (krow0 + key) * NMIX + 2048 + hd * 64 + part * 32;
#pragma unroll
        for (int i = 0; i < (NA ? 4 : 2); ++i) rk[i] = *(const u32x4*)(p + 8 * i);
    } else {
        const int krow = tid >> 2, key = krow >> 1, kvh = krow & 1, part = tid & 3;
        const bf16_t* p = um + (krow0 + key) * NMIX + 1024 + kvh * 64 + part * 16;
        rk[0] = *(const u32x4*)(p); rk[1] = *(const u32x4*)(p + 8);
    }
#pragma unroll
    for (int i = 0; i < (NA ? 4 : 2); ++i) { const int pc = i * 512 + tid, hdd = pc >> 3, part = pc & 7, hd = hdd >> 6, d = hdd & 63;
        rv[i] = *(const u32x4*)(um + (krow0 + d) * NMIX + (NA ? 2304 : 1152) + hd * 64 + part * 8); }
}
template <bool NA>
__device__ __forceinline__ void attn_store_chunk(const u32x4 (&rk)[NA ? 4 : 2], const u32x4 (&rv)[NA ? 4 : 2], LAS bf16_t* Kl, LAS bf16_t* Vt, int tid) {
    if (NA) {
        const int krow = tid >> 1, key = krow >> 2, hd = krow & 3, part = tid & 1;
        LAS bf16_t* dst = Kl + (hd * 64 + key) * 72 + part * 32;
#pragma unroll
        for (int i = 0; i < (NA ? 4 : 2); ++i) *(LAS u32x4*)(dst + 8 * i) = rk[i];
    } else {
        const int krow = tid >> 2, key = krow >> 1, kvh = krow & 1, part = tid & 3;
        LAS bf16_t* dst = Kl + (kvh * 64 + key) * 72 + part * 16;
        *(LAS u32x4*)(dst) = rk[0]; *(LAS u32x4*)(dst + 8) = rk[1];
    }
#pragma unroll
    for (int i = 0; i < (NA ? 4 : 2); ++i) { const int pc = i * 512 + tid, hdd = pc >> 3, part = pc & 7;
        *(LAS u32x4*)(Vt + hdd * 72 + part * 8) = rv[i]; }
}

template <bool NA>
__device__ __forceinline__ void attn_unit(LAS unsigned char* lds, const bf16_t* um, bf16_t* y, const float* gq, const float* gk, const float* sinkp, const float* relb,
                                          const float* ropeC, const float* ropeS, int b, int tb, bool qctx, const int tid) {
    const int wid = __builtin_amdgcn_readfirstlane(tid >> 6), lane = tid & 63, ql = lane & 31, hh = lane >> 5;
    const int h = wid >> 1, qs = wid & 1;
    constexpr int QC = NA ? 1792 : 768, YC = NA ? 768 : 256;
    constexpr float QSCALE = 0.125f * LOG2E;
    LAS bf16_t* Kl = (LAS bf16_t*)lds;
    LAS bf16_t* Vt = (LAS bf16_t*)(lds + 36864);
    LAS float* btab = (LAS float*)(lds + 73728);
    const int qi = qs * 32 + ql;
    const int qtok = tb * 64 + qi;
    const size_t qrow = qctx ? (size_t)ML + b * CTXL + qtok : (size_t)b * SEQ + qtok;
    __syncthreads();
    float bmax = 0.f;
    if (NA) {
#pragma unroll
        for (int w = 0; w < 8; ++w) bmax = fmaxf(bmax, btab[7620 + 112 + w]); }
    bf16x8 qp[4], qr[4]; float mq, qn2 = 0.f;
    {
        float qf[4][8]; float ss = 0.f;
#pragma unroll
        for (int s = 0; s < 4; ++s) { const u32x4 w = *(const u32x4*)(um + qrow * NMIX + QC + h * 64 + 16 * s + 8 * hh); unpack8(w, qf[s]);
#pragma unroll
            for (int j = 0; j < 8; ++j) ss += qf[s][j] * qf[s][j]; }
        ss += __shfl_xor(ss, 32);
        const float rs = rsqrtf(ss * (1.0f / 64.0f) + EPS) * QSCALE;
#pragma unroll
        for (int s = 0; s < 4; ++s) {
#pragma unroll
            for (int j = 0; j < 8; ++j) qf[s][j] *= rs * gq[16 * s + 8 * hh + j] * (NA ? gk[16 * s + 8 * hh + j] : 1.0f);
            qp[s] = pack8(qf[s]);
#pragma unroll
            for (int j = 0; j < 8; ++j) qn2 += qf[s][j] * qf[s][j];
        }
        qn2 += __shfl_xor(qn2, 32);
        if (!NA) {
            const int prow = qtok >> 6, pcol = qtok & 63;
            float r0[8], r1[8], r2[8], r3[8];
#pragma unroll
            for (int j = 0; j < 8; ++j) {
                const int i = 8 * hh + j;
                const float c0 = ropeC[prow * 16 + i], s0 = ropeS[prow * 16 + i], c1 = ropeC[pcol * 16 + i], s1 = ropeS[pcol * 16 + i];
                r0[j] = qf[0][j] * c0 - qf[1][j] * s0; r1[j] = qf[0][j] * s0 + qf[1][j] * c0;
                r2[j] = qf[2][j] * c1 - qf[3][j] * s1; r3[j] = qf[2][j] * s1 + qf[3][j] * c1;
            }
            qr[0] = pack8(r0); qr[1] = pack8(r1); qr[2] = pack8(r2); qr[3] = pack8(r3);
        } else { qr[0] = qp[0]; qr[1] = qp[1]; qr[2] = qp[2]; qr[3] = qp[3]; }
    }
    int kb0, nband;
    if (qctx) { kb0 = 0; nband = 0; }
    else if (NA) { kb0 = tb - 4; kb0 = kb0 < 0 ? 0 : (kb0 > 248 ? 248 : kb0); nband = 8; }
    else { kb0 = tb - 2 < 0 ? 0 : tb - 2; const int kb1 = tb + 2 > 255 ? 255 : tb + 2; nband = kb1 - kb0 + 1; }
    const int nch = 4 + nband;
    float lrun;
    { float kmax = 8.0f;
      if (!NA) { float g = 0.f;
#pragma unroll 8
          for (int d = 0; d < 64; ++d) g = fmaxf(g, fabsf(gk[d]));
          kmax *= g; }
      mq = sqrtf(qn2) * kmax + (NA ? bmax : 0.f) + 1e-3f;
      if (!NA) { const float sk = sinkp[h] * LOG2E; mq = fmaxf(mq, sk); lrun = hh == 0 ? __builtin_amdgcn_exp2f(sk - mq) : 0.f; } else lrun = 0.f; }
    f32x16 O0, O1;
#pragma unroll
    for (int i = 0; i < 16; ++i) { O0[i] = 0.f; O1[i] = 0.f; }
    const int kh = NA ? h : (h >> 1);
    u32x4 rk[NA ? 4 : 2], rv[NA ? 4 : 2];
    attn_load_raw<NA>(rk, rv, um, (size_t)ML + b * CTXL, tid);
    for (int ci = 0; ci < nch; ++ci) {
        const bool band = ci >= 4;
        const int kb = band ? kb0 + (ci - 4) : ci;
        int hh_o = hh, qi_o = qi, tid_o = tid; asm volatile("" : "+v"(hh_o), "+v"(qi_o), "+v"(tid_o) :: "memory");
        __syncthreads();
        attn_store_chunk<NA>(rk, rv, Kl, Vt, tid_o);
        if (ci + 1 < nch) { const int nb = (ci + 1 >= 4) ? kb0 + (ci + 1 - 4) : ci + 1; const size_t r0 = (ci + 1 >= 4) ? (size_t)b * SEQ + nb * 64 : (size_t)ML + b * CTXL + nb * 64; attn_load_raw<NA>(rk, rv, um, r0, tid_o); }
        asm volatile("s_waitcnt lgkmcnt(0)" ::: "memory"); __builtin_amdgcn_s_barrier(); asm volatile("" ::: "memory");
        f32x16 S0, S1;
#pragma unroll
        for (int i = 0; i < 16; ++i) { S0[i] = 0.f; S1[i] = 0.f; }
        const LAS bf16_t* kp = Kl + (kh * 64 + ql) * 72 + 8 * hh;
        const bool rot = band && !NA;
#pragma unroll
        for (int s = 0; s < 4; ++s) {
            const bf16x8 a0 = *(const LAS bf16x8*)(kp + 16 * s), a1 = *(const LAS bf16x8*)(kp + 32 * 72 + 16 * s);
            const bf16x8 q = rot ? qr[s] : qp[s];
            S0 = __builtin_amdgcn_mfma_f32_32x32x16_bf16(a0, q, S0, 0, 0, 0);
            S1 = __builtin_amdgcn_mfma_f32_32x32x16_bf16(a1, q, S1, 0, 0, 0);
        }
        if (band) {
            if (NA) {
                int cs = qi_o - 8; cs = cs < 0 ? 0 : (cs > 48 ? 48 : cs);
                const LAS float* tb_ = btab + (h * 15 + (kb - tb + 7)) * 127 + 4 * hh_o - qi_o + 63;
                const LAS float* tv_ = btab + 7620 + 4 * hh_o - cs + 48;
#pragma unroll
                for (int r = 0; r < 16; ++r) {
                    const int c0 = (r & 3) + 8 * (r >> 2);
                    S0[r] += tb_[c0] + tv_[c0];
                    S1[r] += tb_[c0 + 32] + tv_[c0 + 32];
                }
            } else {
                const int dk = kb - tb;
                if (dk == -2) {
#pragma unroll
                    for (int r = 0; r < 16; ++r) { const int k0 = (r & 3) + 8 * (r >> 2) + 4 * hh_o; if (k0 < qi_o) S0[r] = -1e30f; if (k0 + 32 < qi_o) S1[r] = -1e30f; }
                } else if (dk == 2) {
#pragma unroll
                    for (int r = 0; r < 16; ++r) { const int k0 = (r & 3) + 8 * (r >> 2) + 4 * hh_o; if (k0 > qi_o) S0[r] = -1e30f; if (k0 + 32 > qi_o) S1[r] = -1e30f; }
                }
            }
        }
        float ls = 0.f;
#pragma unroll
        for (int r = 0; r < 16; ++r) { S0[r] = __builtin_amdgcn_exp2f(S0[r] - mq); S1[r] = __builtin_amdgcn_exp2f(S1[r] - mq); ls += S0[r] + S1[r]; }
        lrun += ls;
        bf16x8 pf[2][2];
        { float t[8];
#pragma unroll
          for (int s2 = 0; s2 < 2; ++s2) {
#pragma unroll
              for (int j = 0; j < 8; ++j) t[j] = S0[8 * s2 + j];
              pf[0][s2] = pack8(t);
#pragma unroll
              for (int j = 0; j < 8; ++j) t[j] = S1[8 * s2 + j];
              pf[1][s2] = pack8(t);
          } }
        const LAS bf16_t* vp = Vt + (kh * 64 + ql) * 72 + 4 * hh;
#pragma unroll
        for (int kt = 0; kt < 2; ++kt)
#pragma unroll
            for (int s2 = 0; s2 < 2; ++s2) {
                const int base = 32 * kt + 16 * s2;
                { const u32x2 lo = *(const LAS u32x2*)(vp + base), hi = *(const LAS u32x2*)(vp + base + 8);
                  const u32x4 w = {lo.x, lo.y, hi.x, hi.y};
                  O0 = __builtin_amdgcn_mfma_f32_32x32x16_bf16(__builtin_bit_cast(bf16x8, w), pf[kt][s2], O0, 0, 0, 0); }
                { const u32x2 lo = *(const LAS u32x2*)(vp + 32 * 72 + base), hi = *(const LAS u32x2*)(vp + 32 * 72 + base + 8);
                  const u32x4 w = {lo.x, lo.y, hi.x, hi.y};
                  O1 = __builtin_amdgcn_mfma_f32_32x32x16_bf16(__builtin_bit_cast(bf16x8, w), pf[kt][s2], O1, 0, 0, 0); }
            }
    }
    lrun += __shfl_xor(lrun, 32);
    const float inv = 1.0f / lrun;
    int lane_e = lane; asm volatile("" : "+v"(lane_e));
    const int qtok_e = tb * 64 + qs * 32 + (lane_e & 31);
    const size_t qrow_e = qctx ? (size_t)ML + b * CTXL + qtok_e : (size_t)b * SEQ + qtok_e;
    bf16_t* yp = y + qrow_e * D + YC + h * 64 + 4 * (lane_e >> 5);
#pragma unroll
    for (int g4 = 0; g4 < 4; ++g4) {
        u32x2 w0, w1;
        w0.x = cvt_pk(O0[4 * g4] * inv, O0[4 * g4 + 1] * inv); w0.y = cvt_pk(O0[4 * g4 + 2] * inv, O0[4 * g4 + 3] * inv);
        w1.x = cvt_pk(O1[4 * g4] * inv, O1[4 * g4 + 1] * inv); w1.y = cvt_pk(O1[4 * g4 + 2] * inv, O1[4 * g4 + 3] * inv);
        *(u32x2*)(yp + 8 * g4) = w0; *(u32x2*)(yp + 32 + 8 * g4) = w1;
    }
}

__device__ __forceinline__ unsigned f2bf(float f) { unsigned u = __float_as_uint(f); return (u + 0x7fffu + ((u >> 16) & 1u)) >> 16; }
__device__ __forceinline__ unsigned pk2(float lo, float hi) { return f2bf(lo) | (f2bf(hi) << 16); }

__device__ __forceinline__ void transpose_item(const float* W, int K, int N, bf16_t* WT, int k0, int n0, int drow0, LAS float* scr, int lane) {
#pragma unroll
    for (int i = 0; i < 8; ++i) { const int kk = 8 * i + (lane >> 3), c4 = (lane & 7) * 4; const f32x4 v = *(const f32x4*)(W + (size_t)(k0 + kk) * N + n0 + c4);
        LAS float* d = scr + kk * 33 + c4; d[0] = v.x; d[1] = v.y; d[2] = v.z; d[3] = v.w; }
    asm volatile("s_waitcnt lgkmcnt(0)" ::: "memory");
    const int c = lane & 7;
#pragma unroll
    for (int j = 0; j < 4; ++j) { const int n = (lane >> 3) + 8 * j; const LAS float* s = scr + (8 * c) * 33 + n;
        u32x4 o; o.x = pk2(s[0 * 33], s[1 * 33]); o.y = pk2(s[2 * 33], s[3 * 33]); o.z = pk2(s[4 * 33], s[5 * 33]); o.w = pk2(s[6 * 33], s[7 * 33]);
        *(u32x4*)(WT + (size_t)(drow0 + n) * K + k0 + 8 * c) = o; }
    asm volatile("s_waitcnt lgkmcnt(0)" ::: "memory");
}
__device__ __forceinline__ float gelu_tanh(float x) {
    const float t = 0.7978845608028654f * (x + 0.044715f * x * x * x);
    const float e = __expf(2.0f * t);
    const float th = 1.0f - 2.0f * __builtin_amdgcn_rcpf(e + 1.0f);
    return 0.5f * x * (1.0f + th);
}


__device__ __forceinline__ void ctx_combine(const float* part, const float* xin, float* xout, const float* gate, const float* gs, bf16_t* xs, float* ssq, int gw, int NGW, int lane) {
    for (int r = gw; r < MC; r += NGW) {
        float ss = 0.f;
#pragma unroll
        for (int j = 0; j < 4; ++j) {
            const int col = 4 * lane + 256 * j;
            f32x4 sum = *(const f32x4*)(part + (size_t)r * D + col);
#pragma unroll
            for (int ks = 1; ks < 11; ++ks) sum += *(const f32x4*)(part + ((size_t)ks * MC + r) * D + col);
            const f32x4 x = *(const f32x4*)(xin + (size_t)r * D + col) + *(const f32x4*)(gate + col) * sum;
            *(f32x4*)(xout + (size_t)r * D + col) = x;
            ss += (x.x * x.x + x.y * x.y) + (x.z * x.z + x.w * x.w);
            const f32x4 g = *(const f32x4*)(gs + col);
            u32x2 w; w.x = cvt_pk(x.x * g.x, x.y * g.y); w.y = cvt_pk(x.z * g.z, x.w * g.w);
            *(u32x2*)(xs + (size_t)(ML + r) * D + col) = w;
        }
        ss = wave_sum(ss);
        if (lane < 16) ssq[(size_t)(ML + r) * 16 + lane] = lane == 0 ? ss : 0.f;
    }
}

#define XB_TMO      128
#define XB_XCNT(j)  (256  + 64 * (j))
#define XB_XSUB(j)  (1280 + 64 * (j))
#define XB_XGEN(j)  (2304 + 64 * (j))
#define XB_TOP      3328
#define XB_TOPGEN   3392
#define XB_SPIN_CAP (1u << 18)
__device__ __forceinline__ unsigned xb_ld(unsigned* p)              { return __hip_atomic_load(p, __ATOMIC_RELAXED, __HIP_MEMORY_SCOPE_AGENT); }
__device__ __forceinline__ unsigned xb_add(unsigned* p, unsigned v) { return __hip_atomic_fetch_add(p, v, __ATOMIC_RELAXED, __HIP_MEMORY_SCOPE_AGENT); }
__device__ __forceinline__ unsigned xb_xcc_id() { return (unsigned)__builtin_amdgcn_s_getreg((3 << 11) | 20) & 0xFu; }
#define XB_SPIN(cond, bar) do { unsigned _sp = 0; while (cond) { __builtin_amdgcn_s_sleep(1); \
    if ((++_sp & 255u) == 0u) { if (xb_ld(&(bar)[XB_TMO])) break; if (_sp > XB_SPIN_CAP) { atomicAdd(&(bar)[XB_TMO], 1u); break; } } } } while (0)
__device__ __forceinline__ void xcd_barrier_complete(unsigned* bar, unsigned x, unsigned& nloc, unsigned& nx) {
    const unsigned G = gridDim.x * gridDim.y * gridDim.z;
    unsigned sum, cnt, mine, sp = 0u;
    for (;;) {
        sum = 0u; cnt = 0u; mine = 0u;
#pragma unroll
        for (unsigned j = 0; j < 16; ++j) { const unsigned c = xb_ld(&bar[XB_XCNT(j)]); sum += c; cnt += (c > 0u) ? 1u : 0u; mine = (j == x) ? c : mine; }
        if (sum == G) break;
        __builtin_amdgcn_s_sleep(1);
        if ((++sp & 255u) == 0u) { if (xb_ld(&bar[XB_TMO])) break; if (sp > XB_SPIN_CAP) { atomicAdd(&bar[XB_TMO], 1u); break; } }
    }
    nloc = mine > 0u ? mine : 1u; nx = cnt > 0u ? cnt : 1u;
}
__device__ __forceinline__ void xcd_barrier(unsigned* bar, volatile LAS unsigned* st, int tid) {
    asm volatile("s_waitcnt vmcnt(0)" ::: "memory");
    __syncthreads();
    if (tid == 0) {
        const unsigned x = xb_xcc_id();
        __builtin_amdgcn_s_waitcnt(0);
        unsigned nloc = st[0], nx = st[1];
        if (nloc == 0u) { xcd_barrier_complete(bar, x, nloc, nx); st[0] = nloc; st[1] = nx; }
        const unsigned old = xb_add(&bar[XB_XSUB(x)], 1u);
        const unsigned gen = old / nloc;
        if (old + 1u == (gen + 1u) * nloc) {
            __builtin_amdgcn_fence(__ATOMIC_RELEASE, "agent");
            asm volatile("s_waitcnt vmcnt(0)" ::: "memory");
            const unsigned og = xb_add(&bar[XB_TOP], 1u);
            const unsigned tg = og / nx;
            if (og + 1u == (tg + 1u) * nx) xb_add(&bar[XB_TOPGEN], 1u);
            else XB_SPIN(xb_ld(&bar[XB_TOPGEN]) == tg, bar);
            __builtin_amdgcn_fence(__ATOMIC_ACQUIRE, "agent");
            xb_add(&bar[XB_XGEN(x)], 1u);
            asm volatile("s_waitcnt vmcnt(0)" ::: "memory");
        } else {
            XB_SPIN(xb_ld(&bar[XB_XGEN(x)]) == gen, bar);
            __builtin_amdgcn_fence(__ATOMIC_ACQUIRE, "agent");
            asm volatile("s_waitcnt vmcnt(0)" ::: "memory");
        }
    }
    __syncthreads();
}
constexpr int LDS_BAR_OFF = 139264;

enum { K_CONV = 0, K_PREP, K_FFN_UP0, K_FFN_DN0, K_WIN_A, K_KVPREP, K_MIX, K_LRU_GEMM, K_LRU_SUM, K_LRU_FIN, K_WIN_B0, K_BR0, K_WIN_B1, K_BR1, K_WOUT, K_FFN_UP1, K_FFN_DN1, K_PER_LAYER };
constexpr int N_STEPS = 2 * K_PER_LAYER;

template <int KM> __global__ void __launch_bounds__(512, 2) fwd_mega_t(Params P) {
    extern __shared__ __attribute__((aligned(16))) unsigned char lds_raw[];
    LAS unsigned char* lds = (LAS unsigned char*)lds_raw;
    cg::grid_group grid = cg::this_grid();
    const int wave_k = __builtin_amdgcn_readfirstlane(threadIdx.x >> 6);
    if (P.hi - P.lo > 1) {
        volatile LAS unsigned* st0 = (volatile LAS unsigned*)(lds + LDS_BAR_OFF);
        if (threadIdx.x == 0) { st0[0] = 0u; st0[1] = 0u; (void)xb_add(&((unsigned*)P.ws)[XB_XCNT(xb_xcc_id())], 1u); }
        __syncthreads();
    }

    for (int step = P.lo; step < P.hi; ++step)
    for (int rep = 0; rep < (int)((((unsigned)DBL_MASK) >> (step % K_PER_LAYER)) & 1u) + 1; ++rep) {
        const char __attribute__((address_space(4)))* ka = (const char __attribute__((address_space(4)))*)__builtin_amdgcn_kernarg_segment_ptr();
        asm volatile("" : "+s"(ka));
        int G = gridDim.x, bid = blockIdx.x, wave = wave_k;
        asm volatile("" : "+s"(wave), "+s"(G), "+s"(bid));
        int lane = (int)__builtin_amdgcn_mbcnt_hi(~0u, __builtin_amdgcn_mbcnt_lo(~0u, 0u));
        asm volatile("" : "+v"(lane));
        const int tid = wave * 64 + lane;
#define PIN(i) (*(const float* const __attribute__((address_space(4)))*)(ka + 8 * (i)))
        float* const Pout = *(float* const __attribute__((address_space(4)))*)(ka + 200);
        unsigned char* const ws = *(unsigned char* const __attribute__((address_space(4)))*)(ka + 208);
        float* mod = (float*)(ws + OFF_MOD); float* GS = (float*)(ws + OFF_GS); float* BIAS = (float*)(ws + OFF_BIAS);
        float* ropeC = (float*)(ws + OFF_ROPE); float* ropeS = ropeC + 256 * 16; float* LRUC = (float*)(ws + OFF_LRUC);
        f32x2* SUM = (f32x2*)(ws + OFF_SUM); float* SSQ = (float*)(ws + OFF_SSQ); float* XC = (float*)(ws + OFF_XC);
        bf16_t* W1A = (bf16_t*)(ws + W_W1A); bf16_t* WDA = (bf16_t*)(ws + W_WDA); bf16_t* WIN = (bf16_t*)(ws + W_WIN); bf16_t* WBR = (bf16_t*)(ws + W_WBR);
        bf16_t* WOUT = (bf16_t*)(ws + W_WOUT); bf16_t* W1B = (bf16_t*)(ws + W_W1B); bf16_t* WDB = (bf16_t*)(ws + W_WDB); bf16_t* WLRU = (bf16_t*)(ws + W_WLRU);
        bf16_t* XA = (bf16_t*)(ws + OFF_XA); bf16_t* XB = (bf16_t*)(ws + OFF_XB); bf16_t* ACT = (bf16_t*)(ws + OFF_R); bf16_t* UM = (bf16_t*)(ws + OFF_R);
        bf16_t* GL = (bf16_t*)(ws + OFF_GL); float* AB = (float*)(ws + OFF_GL); float* PART = (float*)(ws + OFF_PART);
        float* sW1a = BIAS; float* sWin = BIAS + 3 * 5632; float* sW1b = sWin + 3 * INW;
        const int l = step / K_PER_LAYER, kind = step % K_PER_LAYER;
        const bool ctx_out = (l == 0);
        const int nMall = ctx_out ? 130 : 128;
        const float* modl = mod + (size_t)l * 3 * NMOD;
        __syncthreads();
        switch (kind) {
        case K_CONV: if (EN(K_CONV)) {
            if (l == 1)
                ctx_combine(PART, XC, XC, mod + 8 * 1024 + 2 * NMOD, GS + (((size_t)1 * 3 + 0) * 3 + 2) * 1024, XA, SSQ, bid * 8 + wave, G * 8, lane);
            LAS float* scr = (LAS float*)(lds + wave * 8448);
            if (l == 0) {
                LAS float* sc = (LAS float*)(lds + 69632);
                LAS float* red = (LAS float*)(lds + 69632 + 12288);
                for (int i = tid; i < 3 * 1024; i += 512) { const int mi = i >> 10, k = i & 1023; const float v = mi < 2 ? PIN(1)[mi * 1024 + k] : PIN(3)[k]; sc[i] = v * fast_sigmoid(v); }
                __syncthreads();
                for (int it = bid; it < 2 * 144; it += G) {
                    const int ll = it / 144, n = (it % 144) * 64 + lane;
                    const float* wm = PIN(4) + (size_t)ll * 1024 * NMOD + n;
                    float a0 = 0.f, a1 = 0.f, a2 = 0.f;
#pragma unroll 8
                    for (int k = wave * 128; k < wave * 128 + 128; ++k) { const float w = wm[(size_t)k * NMOD]; a0 += sc[k] * w; a1 += sc[1024 + k] * w; a2 += sc[2048 + k] * w; }
                    red[(wave * 3 + 0) * 64 + lane] = a0; red[(wave * 3 + 1) * 64 + lane] = a1; red[(wave * 3 + 2) * 64 + lane] = a2;
                    __syncthreads();
                    if (tid < 192) {
                        const int mi = tid >> 6; float s = 0.f;
#pragma unroll
                        for (int w = 0; w < 8; ++w) s += red[(w * 3 + mi) * 64 + lane];
                        s += PIN(5)[ll * NMOD + n];
                        const int j = n >> 10, col = n & 1023;
                        mod[((size_t)ll * 3 + mi) * NMOD + n] = (j == 2 || j == 8) ? 0.5f * s : s;
                        if (j == 1 || j == 4 || j == 7) { const int sidx = j / 3; GS[(((size_t)ll * 3 + sidx) * 3 + mi) * 1024 + col] = PIN(6)[((size_t)ll * 3 + sidx) * 1024 + col] * (1.0f + s); }
                    }
                    __syncthreads();
                }
                for (int i = bid * 512 + tid; i < 256 * 16; i += G * 512) { const int pos = i >> 4, f = i & 15; const float inv = powf(10000.0f, -(float)f / 16.0f); float s, c; sincosf((float)pos * inv, &s, &c); ropeC[i] = c; ropeS[i] = s; }
            }
            const int gw = bid * 8 + wave, NGW = G * 8;
            const float* fg = PIN(7) + (size_t)l * 2 * D * DFF; const float* fu = PIN(8) + (size_t)l * 2 * D * DFF; const float* fd = PIN(9) + (size_t)l * 2 * DFF * D;
            const float* win = PIN(10) + (size_t)l * D * INW; const float* wbr = PIN(23) + (size_t)l * 4 * 256 * D; const float* wo = PIN(24) + (size_t)l * D * D;
            constexpr int I_GU = 16 * 88, I_DN = 44 * 32, I_IN = 16 * 208, I_BR = 4 * 32, I_O = 16 * 32;
            constexpr int NIT = 4 * I_GU + 2 * I_DN + I_IN + 4 * I_BR + I_O;
            for (int it = gw; it < NIT; it += NGW) {
                int r = it;
                if (r < 4 * I_GU) {
                    const int which = r / I_GU; r %= I_GU; const int kb = r / 88, nb = r % 88, n0 = nb * 32;
                    const float* src = ((which & 1) ? fu : fg) + (size_t)(which >> 1) * D * DFF;
                    transpose_item(src, D, DFF, (which >> 1) ? W1B : W1A, kb * 64, n0, (n0 >> 7) * 256 + (n0 & 127) + ((which & 1) ? 128 : 0), scr, lane); continue; }
                r -= 4 * I_GU;
                if (r < 2 * I_DN) { const int which = r / I_DN; r %= I_DN; const int kb = r / 32, nb = r % 32;
                    transpose_item(fd + (size_t)which * DFF * D, DFF, D, which ? WDB : WDA, kb * 64, nb * 32, nb * 32, scr, lane); continue; }
                r -= 2 * I_DN;
                if (r < I_IN) { const int kb = r / 208, nb = r % 208; transpose_item(win, D, INW, WIN, kb * 64, nb * 32, nb * 32, scr, lane); continue; }
                r -= I_IN;
                if (r < 4 * I_BR) { const int b = r / I_BR; r %= I_BR; const int kb = r / 32, nb = r % 32;
                    transpose_item(wbr + (size_t)b * 256 * D, 256, D, WBR + (size_t)b * 1024 * 256, kb * 64, nb * 32, nb * 32, scr, lane); continue; }
                r -= 4 * I_BR;
                { const int kb = r / 32, nb = r % 32; transpose_item(wo, D, D, WOUT, kb * 64, nb * 32, nb * 32, scr, lane); }
            }
            if (bid == 0) { const int i = tid; LRUC[i] = PIN(18)[(size_t)l * 512 + i]; LRUC[512 + i] = PIN(20)[(size_t)l * 512 + i]; LRUC[1024 + i] = -8.0f * log1pf(__expf(-PIN(21)[(size_t)l * 512 + i])); }
            const float* wa = PIN(17) + (size_t)l * 2 * 4 * 64 * 64; const float* wx = PIN(19) + (size_t)l * 2 * 4 * 64 * 64;
            for (int i = bid * 512 + tid; i < 1024 * 32; i += G * 512) {
                const int row = i >> 5, k0 = (i & 31) * 8;
                const int pn = row >> 8, within = row & 255, typ = within >> 7, ch = (pn & 1) * 128 + (within & 127), dir = pn >> 1, nblk = ch >> 6, e = ch & 63;
                const float* src = (typ ? wx : wa) + ((size_t)(dir * 4 + nblk) * 64) * 64 + e;
                float v[8];
#pragma unroll
                for (int j = 0; j < 8; ++j) { const int k = k0 + j; v[j] = ((k >> 6) == nblk) ? src[(size_t)(k & 63) * 64] : 0.f; }
                u32x4 o; o.x = pk2(v[0], v[1]); o.y = pk2(v[2], v[3]); o.z = pk2(v[4], v[5]); o.w = pk2(v[6], v[7]);
                *(u32x4*)(WLRU + (size_t)row * 256 + k0) = o;
            }
        } break;
        case K_PREP: if (EN(K_PREP)) {
            const int gw = bid * 8 + wave, NGW = G * 8;
            for (int r = gw; r < 5632 + INW + 5632; r += NGW) {
                const bf16_t* wrow; int sidx; float* dst; int dstride; int rr = r; float extra = 0.f;
                if (rr < 5632) { wrow = W1A + (size_t)rr * D; sidx = 0; dst = sW1a + rr; dstride = 5632; }
                else if (rr < 5632 + INW) { rr -= 5632; wrow = WIN + (size_t)rr * D; sidx = 3; dst = sWin + rr; dstride = INW; if (rr >= NMIX) extra = PIN(11)[(size_t)l * 4096 + rr - NMIX]; }
                else { rr -= 5632 + INW; wrow = W1B + (size_t)rr * D; sidx = 6; dst = sW1b + rr; dstride = 5632; }
                float a0 = 0.f, a1 = 0.f, a2 = 0.f;
#pragma unroll
                for (int hf = 0; hf < 2; ++hf) {
                    const int k = hf * 512 + lane * 8; float wv[8]; unpack8(*(const u32x4*)(wrow + k), wv);
                    const float* s0 = modl + sidx * 1024 + k;
#pragma unroll
                    for (int j = 0; j < 8; ++j) { a0 += wv[j] * s0[j]; a1 += wv[j] * s0[NMOD + j]; a2 += wv[j] * s0[2 * NMOD + j]; }
                }
                a0 = wave_sum(a0); a1 = wave_sum(a1); a2 = wave_sum(a2);
                if (lane == 0) { dst[0] = a0 + extra; dst[dstride] = a1 + extra; dst[2 * dstride] = a2 + extra; }
            }
            if (l == 0) {
                for (int row = gw; row < MT; row += NGW) {
                    const float* xr = row < ML ? PIN(0) + (size_t)row * D : PIN(2) + (size_t)(row - ML) * D;
                    const int mi = row < SEQ ? 0 : (row < ML ? 1 : 2);
                    const float* gs = GS + (size_t)mi * 1024;
                    float ss = 0.f;
#pragma unroll
                    for (int j = 0; j < 4; ++j) {
                        const f32x4 v = *(const f32x4*)(xr + 4 * lane + 256 * j), g = *(const f32x4*)(gs + 4 * lane + 256 * j);
                        ss += (v.x * v.x + v.y * v.y) + (v.z * v.z + v.w * v.w);
                        u32x2 w; w.x = cvt_pk(v.x * g.x, v.y * g.y); w.y = cvt_pk(v.z * g.z, v.w * g.w);
                        *(u32x2*)(XA + (size_t)row * D + 4 * lane + 256 * j) = w;
                    }
                    ss = wave_sum(ss);
                    if (lane < 16) SSQ[(size_t)row * 16 + lane] = lane == 0 ? ss : 0.f;
                }
            }
        } break;
        case K_FFN_UP0: case K_FFN_UP1: if (EN(K_FFN_UP0)) {
            const bool second = kind == K_FFN_UP1;
            const int nM = second ? nMall : 130;
            pg8::SchedStd S; S.init(0, nM, 22, G, bid, second ? XB : XA, D, second ? W1B : W1A, D, D);
            pg8::EpiSwiGLU E{SSQ, second ? sW1b : sW1a, ACT};
            pg8::gemm_phase<pg8::EpiSwiGLU, pg8::SchedStd, 2>(lds, tid, D, D, D, S, E);
        } break;
        case K_FFN_DN0: case K_FFN_DN1: case K_WOUT: if (EN(K_FFN_DN0)) {
            const bool first_in = (l == 0 && kind == K_FFN_DN0);
            const bool last_out = (l == 1 && kind == K_FFN_DN1);
            const int nM = (kind == K_FFN_DN0) ? 130 : nMall;
            const bf16_t* A = (kind == K_WOUT) ? XA : ACT; const bf16_t* Bt = (kind == K_WOUT) ? WOUT : (kind == K_FFN_DN0 ? WDA : WDB);
            const int K = (kind == K_WOUT) ? D : DFF;
            const int gidx = (kind == K_FFN_DN0) ? 2 : (kind == K_WOUT ? 5 : 8);
            const int gsidx = (kind == K_FFN_DN0) ? l * 3 + 1 : (kind == K_WOUT ? l * 3 + 2 : (last_out ? 0 : l * 3 + 3));
            const float* gsn = GS + (size_t)gsidx * 3072;
            bf16_t* xs = (kind == K_WOUT) ? XB : XA;
            const bool split_ctx = (kind != K_WOUT) && (nM == 130);
            pg8::SchedDn S; S.std.init(0, split_ctx ? 128 : nM, 4, G, bid, A, K, Bt, K, K); S.nctx = split_ctx ? 88 : 0;
            pg8::EpiRes E{first_in ? PIN(0) : Pout, first_in ? PIN(2) : XC, Pout, XC, modl + gidx * 1024, gsn, xs, SSQ, PART, last_out ? 0 : 1};
            pg8::gemm_phase<pg8::EpiRes, pg8::SchedDn, 2>(lds, tid, K, K, K, S, E);
        } break;
        case K_WIN_A: if (EN(K_WIN_A)) {
            ctx_combine(PART, l == 0 ? PIN(2) : XC, XC, modl + 2 * 1024 + 2 * NMOD, GS + (((size_t)l * 3 + 1) * 3 + 2) * 1024, XA, SSQ, bid * 8 + wave, G * 8, lane);
            xcd_barrier((unsigned*)ws, (volatile LAS unsigned*)(lds + LDS_BAR_OFF), tid);
            pg8::SchedStd S; S.init(0, 130, 10, G, bid, XA, D, WIN, D, D);
            pg8::EpiLin<0> E{SSQ, sWin, INW, UM, NMIX, 0};
            pg8::gemm_phase<pg8::EpiLin<0>, pg8::SchedStd, 2>(lds, tid, D, D, D, S, E);
        } break;
        case K_WIN_B0: case K_WIN_B1: if (EN(K_WIN_B0)) {
            const int m0 = kind == K_WIN_B0 ? 0 : 64, nM = kind == K_WIN_B0 ? 64 : (nMall - 64);
            pg8::SchedStd S; S.init(m0, nM, 16, G, bid, XA, D, WIN + (size_t)NMIX * D, D, D);
            pg8::EpiLin<1> E{SSQ, sWin + NMIX, INW, GL, 4096, m0 * 256};
            pg8::gemm_phase<pg8::EpiLin<1>, pg8::SchedStd, 2>(lds, tid, D, D, D, S, E);
        } break;
        case K_BR0: case K_BR1: if (EN(K_BR0)) {
            const int m0 = kind == K_BR0 ? 0 : 64, nM = kind == K_BR0 ? 64 : (nMall - 64);
            pg8::SchedBr S{m0, nM, G, bid, (const char*)XB, (const char*)WBR};
            pg8::EpiBranch E{GL, m0 * 256, XA};
            pg8::gemm_phase<pg8::EpiBranch, pg8::SchedBr, 1>(lds, tid, 256, D, 256, S, E);
        } break;
        case K_LRU_GEMM: if (EN(K_LRU_GEMM)) {
            int Kh = 128; asm volatile("" : "+s"(Kh)); pg8::SchedStd S; S.init(0, 130, 4, G, bid, XB + 512, D, WLRU, 256, Kh); S.kofs = 256;
            pg8::EpiLru E{XB, LRUC, (unsigned*)AB};
            int Kq = 256; asm volatile("" : "+s"(Kq));
            pg8::gemm_phase<pg8::EpiLru, pg8::SchedStd, 2>(lds, tid, Kq, D, 256, S, E);
        } break;
        case K_KVPREP: if (EN(K_KVPREP)) {
            LAS bf16_t* Vt6 = (LAS bf16_t*)lds;
            const float* gkb = PIN(13) + (size_t)l * 256 + 64;
            for (int blk = bid; blk < 520; blk += G) {
                const bool lat = blk < 512;
                const size_t row0 = lat ? (size_t)blk * 64 : (size_t)ML + (blk - 512) * 64;
                const int tok0 = lat ? (blk & 255) * 64 : 0;
                __syncthreads();
                {
                    const int krow = tid >> 2, key = krow >> 1, kvh = krow & 1, part = tid & 3;
                    bf16_t* p = UM + (row0 + key) * NMIX + 1024 + kvh * 64 + part * 16;
                    float v[16]; unpack8(*(const u32x4*)(p), v); unpack8(*(const u32x4*)(p + 8), v + 8);
                    float ss = 0.f;
#pragma unroll
                    for (int e = 0; e < 16; ++e) ss += v[e] * v[e];
                    ss += __shfl_xor(ss, 1); ss += __shfl_xor(ss, 2);
                    const float rs = rsqrtf(ss * (1.0f / 64.0f) + EPS);
#pragma unroll
                    for (int e = 0; e < 16; ++e) v[e] *= rs * gkb[part * 16 + e];
                    if (lat) {
                        const int ktok = tok0 + key, pos = (part < 2) ? (ktok >> 6) : (ktok & 63);
#pragma unroll
                        for (int e = 0; e < 16; ++e) { const float pv = __shfl_xor(v[e], 1), c = ropeC[pos * 16 + e], sn = ropeS[pos * 16 + e]; v[e] = (part & 1) ? (pv * sn + v[e] * c) : (v[e] * c - pv * sn); }
                    }
                    *(bf16x8*)(p) = pack8(v); *(bf16x8*)(p + 8) = pack8(v + 8);
                }
                {
                    const int krow = tid >> 1, key = krow >> 2, hd = krow & 3, part = tid & 1;
                    bf16_t* p = UM + (row0 + key) * NMIX + 2048 + hd * 64 + part * 32;
                    float v[32];
#pragma unroll
                    for (int i = 0; i < 4; ++i) unpack8(*(const u32x4*)(p + 8 * i), v + 8 * i);
                    float ss = 0.f;
#pragma unroll
                    for (int e = 0; e < 32; ++e) ss += v[e] * v[e];
                    ss += __shfl_xor(ss, 1);
                    const float rs = rsqrtf(ss * (1.0f / 64.0f) + EPS);
#pragma unroll
                    for (int e = 0; e < 32; ++e) v[e] *= rs;
#pragma unroll
                    for (int i = 0; i < 4; ++i) *(bf16x8*)(p + 8 * i) = pack8(v + 8 * i);
                }
                {
                    const int key = tid >> 3, piece = tid & 7;
                    {
                        const u32x4 a = *(const u32x4*)(UM + (row0 + key) * NMIX + 1152 + piece * 16), b2 = *(const u32x4*)(UM + (row0 + key) * NMIX + 1152 + piece * 16 + 8);
                        const int hd = piece >> 2, d0 = (piece & 3) * 16;
                        LAS bf16_t* vd = Vt6 + (hd * 64 + d0) * 72 + key;
                        const unsigned w[8] = {a.x, a.y, a.z, a.w, b2.x, b2.y, b2.z, b2.w};
#pragma unroll
                        for (int q = 0; q < 8; ++q) { vd[(2 * q) * 72] = (bf16_t)(w[q] & 0xffffu); vd[(2 * q + 1) * 72] = (bf16_t)(w[q] >> 16); }
                    }
                    {
                        const bf16_t* q0 = UM + (row0 + key) * NMIX + 2304 + piece * 32;
                        const int hd = 2 + (piece >> 1), d0 = (piece & 1) * 32;
                        LAS bf16_t* vd = Vt6 + (hd * 64 + d0) * 72 + key;
#pragma unroll
                        for (int i = 0; i < 4; ++i) { const u32x4 a = *(const u32x4*)(q0 + 8 * i); const unsigned w[4] = {a.x, a.y, a.z, a.w};
#pragma unroll
                            for (int q = 0; q < 4; ++q) { vd[(8 * i + 2 * q) * 72] = (bf16_t)(w[q] & 0xffffu); vd[(8 * i + 2 * q + 1) * 72] = (bf16_t)(w[q] >> 16); } }
                    }
                    __syncthreads();
#pragma unroll
                    for (int i = 0; i < 6; ++i) { const int pc = i * 512 + tid, hdd = pc >> 3, part = pc & 7, hd6 = hdd >> 6, d = hdd & 63;
                        const u32x4 v = *(const LAS u32x4*)(Vt6 + hdd * 72 + part * 8);
                        *(u32x4*)(UM + (row0 + d) * NMIX + (hd6 < 2 ? 1152 + hd6 * 64 : 2304 + (hd6 - 2) * 64) + part * 8) = v; }
                }
            }
        } break;
        case K_MIX: if (EN(K_MIX)) {
            const int nctx = ctx_out ? 8 : 0;
            const int nunits = 1024 + 2 * nctx + 520;
            const float* qkg = PIN(13) + (size_t)l * 256;
            { LAS float* btab = (LAS float*)(lds + 73728); const float* relb = PIN(22) + (size_t)l * 4 * 15 * 31;
              for (int i = tid; i < 7620; i += 512) { const int hd = i / 1905, rem = i % 1905, dr = rem / 127, d = rem % 127 - 63; btab[i] = (d >= -15 && d <= 15) ? relb[(hd * 15 + dr) * 31 + d + 15] * LOG2E : 0.f; }
              if (tid < 112) { const int kk = tid - 48; btab[7620 + tid] = (kk >= 0 && kk < 16) ? 0.f : -1e30f; }
              { float bm = 0.f; for (int i = tid; i < 4 * 15 * 31; i += 512) bm = fmaxf(bm, fabsf(relb[i]));
#pragma unroll
                for (int o = 1; o < 64; o <<= 1) bm = fmaxf(bm, __shfl_xor(bm, o));
                if (lane == 0) btab[7620 + 112 + wave] = bm * LOG2E; } }
            for (int uidx = bid; uidx < nunits; uidx += G) {
                int tidm = tid; asm volatile("" : "+v"(tidm));
                const int tbx = ((uidx & 7) << 5) | ((uidx & 255) >> 3);
                if (uidx < 512) attn_unit<false>(lds, UM, XB, qkg, qkg + 64, PIN(14) + l * 4, nullptr, ropeC, ropeS, uidx >> 8, tbx, false, tidm);
                else if (uidx < 1024) attn_unit<true>(lds, UM, XB, qkg + 128, qkg + 192, nullptr, PIN(22) + (size_t)l * 4 * 15 * 31, ropeC, ropeS, (uidx - 512) >> 8, tbx, false, tidm);
                else if (uidx < 1024 + nctx) { const int v = uidx - 1024; attn_unit<false>(lds, UM, XB, qkg, qkg + 64, PIN(14) + l * 4, nullptr, ropeC, ropeS, v >> 2, v & 3, true, tidm); }
                else if (uidx < 1024 + 2 * nctx) { const int v = uidx - 1024 - nctx; attn_unit<true>(lds, UM, XB, qkg + 128, qkg + 192, nullptr, PIN(22) + (size_t)l * 4 * 15 * 31, ropeC, ropeS, v >> 2, v & 3, true, tidm); }
                else {
                    const int v = uidx - 1024 - 2 * nctx;
                    int rowbase, t0, T;
                    if (v < 512) { rowbase = (v >> 8) * SEQ; t0 = (v & 255) * 64; T = SEQ; } else { const int c = v - 512; rowbase = ML + (c >> 2) * CTXL; t0 = (c & 3) * 64; T = CTXL; }
                    const int c8 = (tidm & 31) * 8, tr = tidm >> 5;
                    float wA[3][8], wL[4][8], bL[8];
#pragma unroll
                    for (int k = 0; k < 3; ++k)
#pragma unroll
                        for (int j = 0; j < 8; ++j) wA[k][j] = PIN(12)[((size_t)l * 3 + k) * 256 + c8 + j];
#pragma unroll
                    for (int k = 0; k < 4; ++k)
#pragma unroll
                        for (int j = 0; j < 8; ++j) wL[k][j] = PIN(15)[((size_t)l * 4 + k) * 256 + c8 + j];
#pragma unroll
                    for (int j = 0; j < 8; ++j) bL[j] = PIN(16)[(size_t)l * 256 + c8 + j];
                    for (int ps = 0; ps < 4; ++ps) {
                        const int t = t0 + ps * 16 + tr;
                        const bf16_t* ur = UM + (size_t)(rowbase + t) * NMIX;
                        float accA[8], accL[8];
#pragma unroll
                        for (int j = 0; j < 8; ++j) { accA[j] = 0.f; accL[j] = bL[j]; }
#pragma unroll
                        for (int k = 0; k < 3; ++k) { const int tt = t + k - 1; if (tt >= 0 && tt < T) { const bf16_t* p = ur + (ptrdiff_t)(k - 1) * NMIX; float a[8], c[8]; unpack8(*(const u32x4*)(p + c8), a); unpack8(*(const u32x4*)(p + 512 + c8), c);
#pragma unroll
                                for (int j = 0; j < 8; ++j) accA[j] += wA[k][j] * (a[j] * c[j]); } }
#pragma unroll
                        for (int k = 0; k < 4; ++k) { const int tt = t + k - 2; if (tt >= 0 && tt < T) { float a[8]; unpack8(*(const u32x4*)(ur + (ptrdiff_t)(k - 2) * NMIX + 1280 + c8), a);
#pragma unroll
                                for (int j = 0; j < 8; ++j) accL[j] += wL[k][j] * a[j]; } }
                        float gb[8]; unpack8(*(const u32x4*)(ur + 256 + c8), gb);
                        u32x4 o; o.x = cvt_pk(gb[0] * accA[0], gb[1] * accA[1]); o.y = cvt_pk(gb[2] * accA[2], gb[3] * accA[3]); o.z = cvt_pk(gb[4] * accA[4], gb[5] * accA[5]); o.w = cvt_pk(gb[6] * accA[6], gb[7] * accA[7]);
                        bf16_t* yr = XB + (size_t)(rowbase + t) * D;
                        *(u32x4*)(yr + c8) = o;
                        u32x4 o2; o2.x = cvt_pk(accL[0], accL[1]); o2.y = cvt_pk(accL[2], accL[3]); o2.z = cvt_pk(accL[4], accL[5]); o2.w = cvt_pk(accL[6], accL[7]);
                        *(u32x4*)(yr + 512 + c8) = o2;
                    }
                }
            }
        } break;
        case K_LRU_SUM: if (EN(K_LRU_SUM)) {
            const int dir = tid >> 8, ch = tid & 255;
            for (int cid = bid; cid < 260; cid += 2 * G) {
                const int cid2 = cid + G;
                const bool two = cid2 < 260;
                const int row0 = cid < 256 ? cid * 128 : ML + (cid - 256) * 128;
                const int row1 = two ? (cid2 < 256 ? cid2 * 128 : ML + (cid2 - 256) * 128) : row0;
                const unsigned* a = (const unsigned*)AB + ((size_t)dir * MT + row0) * 256 + ch;
                const unsigned* a2 = (const unsigned*)AB + ((size_t)dir * MT + row1) * 256 + ch;
                float Ap = 1.f, H = 0.f, Ap2 = 1.f, H2 = 0.f;
                if (!two) {
                    if (dir == 0) {
#pragma unroll 16
                        for (int t = 0; t < 128; ++t) { const unsigned w = a[(size_t)t * 256]; const float av = 1.0f - bflo(w), bv = bfhi(w); H = av * H + bv; Ap *= av; }
                    } else {
#pragma unroll 16
                        for (int t = 127; t >= 0; --t) { const unsigned w = a[(size_t)t * 256]; const float av = 1.0f - bflo(w), bv = bfhi(w); H = av * H + bv; Ap *= av; }
                    }
                } else {
                    if (dir == 0) {
#pragma unroll 8
                        for (int t = 0; t < 128; ++t) { const unsigned w = a[(size_t)t * 256], w2 = a2[(size_t)t * 256]; const float av = 1.0f - bflo(w), bv = bfhi(w), av2 = 1.0f - bflo(w2), bv2 = bfhi(w2);
                            H = av * H + bv; Ap *= av; H2 = av2 * H2 + bv2; Ap2 *= av2; }
                    } else {
#pragma unroll 8
                        for (int t = 127; t >= 0; --t) { const unsigned w = a[(size_t)t * 256], w2 = a2[(size_t)t * 256]; const float av = 1.0f - bflo(w), bv = bfhi(w), av2 = 1.0f - bflo(w2), bv2 = bfhi(w2);
                            H = av * H + bv; Ap *= av; H2 = av2 * H2 + bv2; Ap2 *= av2; }
                    }
                    SUM[((size_t)dir * 260 + cid2) * 256 + ch] = (f32x2){Ap2, H2};
                }
                SUM[((size_t)dir * 260 + cid) * 256 + ch] = (f32x2){Ap, H};
            }
        } break;
        case K_LRU_FIN: if (EN(K_LRU_FIN)) {
            LAS bf16_t* hb16 = (LAS bf16_t*)lds;
            bf16_t* SCR = (bf16_t*)PART;
            const int dir = tid >> 8, ch = tid & 255;
            for (int cid = bid; cid < 256; cid += G) {
                __syncthreads();
                const bool two = ctx_out && cid < 4;
                const int b = cid >> 7, c = cid & 127;
                const int row0 = cid * 128, row1 = ML + cid * 128;
                const int nctxc = 2;
                const int nlat = dir == 0 ? c : 127 - c;
                const int ntot = nctxc + nlat;
                const f32x2* sp = SUM + (size_t)dir * 260 * 256 + ch;
                float H = 0.f;
                for (int k0 = 0; k0 < ntot; k0 += 8) {
                    f32x2 sv[8];
#pragma unroll
                    for (int j = 0; j < 8; ++j) {
                        const int k = k0 + j; const bool ok = k < ntot; const int kk = ok ? k : 0;
                        const int id = kk < nctxc ? 256 + 2 * b + (dir == 0 ? kk : 1 - kk) : 128 * b + (dir == 0 ? (kk - nctxc) : 127 - (kk - nctxc));
                        const f32x2 v = sp[(size_t)id * 256];
                        sv[j] = ok ? v : (f32x2){1.f, 0.f};
                    }
#pragma unroll
                    for (int j = 0; j < 8; ++j) H = sv[j].x * H + sv[j].y;
                }
                const unsigned* ap = (const unsigned*)AB + ((size_t)dir * MT + row0) * 256 + ch;
                LAS bf16_t* hp = hb16 + dir * (128 * 256) + ch;
                float h = H;
                if (!two) {
                    if (dir == 0) {
#pragma unroll 16
                        for (int t = 0; t < 128; ++t) { const unsigned w = ap[(size_t)t * 256]; h = (1.0f - bflo(w)) * h + bfhi(w); hp[t * 256] = (bf16_t)f2bf(h); }
                    } else {
#pragma unroll 16
                        for (int t = 127; t >= 0; --t) { const unsigned w = ap[(size_t)t * 256]; h = (1.0f - bflo(w)) * h + bfhi(w); hp[t * 256] = (bf16_t)f2bf(h); }
                    }
                } else {
                    const int c2 = cid & 1, b2 = cid >> 1;
                    const bool has = dir == 0 ? (c2 == 1) : (c2 == 0);
                    float h2 = has ? sp[(size_t)(256 + 2 * b2 + (dir == 0 ? 0 : 1)) * 256].y : 0.f;
                    const unsigned* ap2 = (const unsigned*)AB + ((size_t)dir * MT + row1) * 256 + ch;
                    bf16_t* gp = SCR + ((size_t)(cid * 2 + dir) * 128) * 256 + ch;
                    if (dir == 0) {
#pragma unroll 8
                        for (int t = 0; t < 128; ++t) { const unsigned w = ap[(size_t)t * 256], w2 = ap2[(size_t)t * 256];
                            h = (1.0f - bflo(w)) * h + bfhi(w); hp[t * 256] = (bf16_t)f2bf(h); h2 = (1.0f - bflo(w2)) * h2 + bfhi(w2); gp[(size_t)t * 256] = (bf16_t)f2bf(h2); }
                    } else {
#pragma unroll 8
                        for (int t = 127; t >= 0; --t) { const unsigned w = ap[(size_t)t * 256], w2 = ap2[(size_t)t * 256];
                            h = (1.0f - bflo(w)) * h + bfhi(w); hp[t * 256] = (bf16_t)f2bf(h); h2 = (1.0f - bflo(w2)) * h2 + bfhi(w2); gp[(size_t)t * 256] = (bf16_t)f2bf(h2); }
                    }
                }
                __syncthreads();
#pragma unroll 2
                for (int g = 0; g < 8; ++g) {
                    const int idx = g * 512 + tid, t = idx >> 5, c8 = (idx & 31) * 8;
                    float f[8], r[8], gg[8];
                    unpack8(*(const LAS u32x4*)(hb16 + t * 256 + c8), f); unpack8(*(const LAS u32x4*)(hb16 + 128 * 256 + t * 256 + c8), r);
                    unpack8(*(const u32x4*)(UM + (size_t)(row0 + t) * NMIX + 1536 + c8), gg);
                    u32x4 o; o.x = cvt_pk((f[0] + r[0]) * gelu_tanh(gg[0]), (f[1] + r[1]) * gelu_tanh(gg[1])); o.y = cvt_pk((f[2] + r[2]) * gelu_tanh(gg[2]), (f[3] + r[3]) * gelu_tanh(gg[3]));
                    o.z = cvt_pk((f[4] + r[4]) * gelu_tanh(gg[4]), (f[5] + r[5]) * gelu_tanh(gg[5])); o.w = cvt_pk((f[6] + r[6]) * gelu_tanh(gg[6]), (f[7] + r[7]) * gelu_tanh(gg[7]));
                    *(u32x4*)(XB + (size_t)(row0 + t) * D + 512 + c8) = o;
                }
                if (two) {
                    const bf16_t* s0 = SCR + ((size_t)(cid * 2 + 0) * 128) * 256; const bf16_t* s1 = SCR + ((size_t)(cid * 2 + 1) * 128) * 256;
#pragma unroll 2
                    for (int g = 0; g < 8; ++g) {
                        const int idx = g * 512 + tid, t = idx >> 5, c8 = (idx & 31) * 8;
                        float f[8], r[8], gg[8];
                        unpack8(*(const u32x4*)(s0 + t * 256 + c8), f); unpack8(*(const u32x4*)(s1 + t * 256 + c8), r);
                        unpack8(*(const u32x4*)(UM + (size_t)(row1 + t) * NMIX + 1536 + c8), gg);
                        u32x4 o; o.x = cvt_pk((f[0] + r[0]) * gelu_tanh(gg[0]), (f[1] + r[1]) * gelu_tanh(gg[1])); o.y = cvt_pk((f[2] + r[2]) * gelu_tanh(gg[2]), (f[3] + r[3]) * gelu_tanh(gg[3]));
                        o.z = cvt_pk((f[4] + r[4]) * gelu_tanh(gg[4]), (f[5] + r[5]) * gelu_tanh(gg[5])); o.w = cvt_pk((f[6] + r[6]) * gelu_tanh(gg[6]), (f[7] + r[7]) * gelu_tanh(gg[7]));
                        *(u32x4*)(XB + (size_t)(row1 + t) * D + 512 + c8) = o;
                    }
                }
            }
        } break;
        default: break;
        }
        if (step + 1 < P.hi || rep == 0) {
            if (P.hi < 0) grid.sync();
            xcd_barrier((unsigned*)ws, (volatile LAS unsigned*)(lds + LDS_BAR_OFF), tid);
        }
        for (int xs = 0; xs < XSYNC; ++xs) xcd_barrier((unsigned*)ws, (volatile LAS unsigned*)(lds + LDS_BAR_OFF), tid);
    }
}

extern "C" void kernel_launch(void* const* d_in, const int* in_sizes, int n_in, void* d_out, int out_size, void* d_ws, size_t ws_size, hipStream_t stream) {
    static int grid = 0;
    if (grid == 0) {
        if (n_in != 25 || out_size != ML * D || ws_size < WS_NEED) { fprintf(stderr, "kernel_launch: unexpected shapes (n_in %d out %d ws %zu need %zu)\n", n_in, out_size, ws_size, (size_t)WS_NEED); grid = -1; return; }
        int dev = 0, cus = 0, per_cu = 0;
        (void)hipGetDevice(&dev);
        (void)hipDeviceGetAttribute(&cus, hipDeviceAttributeMultiprocessorCount, dev);
        (void)hipFuncSetAttribute((const void*)fwd_mega_t<KMASK>, hipFuncAttributeMaxDynamicSharedMemorySize, LDS_BYTES);
        (void)hipOccupancyMaxActiveBlocksPerMultiprocessor(&per_cu, (const void*)fwd_mega_t<KMASK>, 512, LDS_BYTES);
        if (per_cu < 1) per_cu = 1;
        (void)hipGetLastError();
        grid = cus * 1;
        fprintf(stderr, "kernel_launch: cus %d per_cu %d grid %d ws %zu\n", cus, per_cu, grid, ws_size);
    }
    if (grid < 0) return;
    Params p{};
    for (int i = 0; i < 25; ++i) p.in[i] = (const float*)d_in[i];
    p.out = (float*)d_out; p.ws = (unsigned char*)d_ws;
    (void)hipMemsetAsync(d_ws, 0, 65536, stream);
    p.lo = 0; p.hi = N_STEPS;
    void* args[] = {&p};
    hipError_t e = hipLaunchCooperativeKernel((const void*)fwd_mega_t<KMASK>, dim3(grid), dim3(512), args, LDS_BYTES, stream);
    if (e != hipSuccess) fprintf(stderr, "cooperative launch failed: %s (grid %d)\n", hipGetErrorString(e), grid);
}
```
